# Optimizing an MI355X kernel written in HIP

```python
import jax, jax.numpy as jnp
from jax import lax
import numpy as np

D_MODEL = 2048
BATCH = 16
SEQ = 2048
DEPTH = 4

N_MIXERS = 2
N_A_LAYERS = (DEPTH + 1) // 2
N_B_LAYERS = DEPTH // 2

HG_EXPAND = 128
HG_HEADS = D_MODEL // HG_EXPAND
HG_FDIM = HG_HEADS * HG_EXPAND
HG_VDIM = D_MODEL
HG_HEAD_V = HG_VDIM // HG_HEADS
HG_CHUNK = 64
HG_SUB = 16
LB_FLOOR = 1e-30

GM_WIDTH = D_MODEL
GM_GROUPS = 16
GM_GROUP_DIM = GM_WIDTH // GM_GROUPS
GM_CHUNK = 128

FFN_HIDDEN = -(-8 * D_MODEL // (3 * 256)) * 256

PLE_DIM = 256

EPS = 1e-6

kernel_name = "hgrn2_gmlp_interleaved_sandwich_ple"


def _rmsnorm(x, g):
    xf = x.astype(jnp.float32)
    y = xf * lax.rsqrt(jnp.mean(xf * xf, axis=-1, keepdims=True) + EPS)
    return (y * g.astype(jnp.float32)).astype(x.dtype)


def _layernorm(x, g, b):
    xf = x.astype(jnp.float32)
    mu = jnp.mean(xf, axis=-1, keepdims=True)
    xc = xf - mu
    y = xc * lax.rsqrt(jnp.mean(xc * xc, axis=-1, keepdims=True) + EPS)
    return (y * g.astype(jnp.float32) + b.astype(jnp.float32)).astype(x.dtype)


def _hgrn_lower_bounds(lb_logits):
    sm = jax.nn.softmax(lb_logits.astype(jnp.float32), axis=0)
    return jnp.cumsum(sm, axis=0) - sm[:1]


def _hgrn2_chunkwise(q, k, v, log_f):
    B, S, H, K = q.shape
    V = v.shape[-1]
    C, L = HG_CHUNK, HG_SUB
    n = C // L
    nc = S // C

    def to_chunks(t):
        return t.reshape(B, nc, C, H, t.shape[-1]).transpose(1, 0, 3, 2, 4)

    causal = jnp.tril(jnp.ones((L, L), dtype=bool))[:, :, None]
    sub_mask = jnp.tril(jnp.ones((n, n), dtype=bool), k=-1)[:, :, None, None]
    eye_n = jnp.eye(n, dtype=jnp.float32)[:, None, :, None]

    def step(state, inp):
        qc, kc, vc, gc = inp
        b = jnp.cumsum(gc, axis=2)
        o_inter = jnp.einsum('bhtk,bhkv->bhtv', qc * jnp.exp(b), state)
        qs = qc.reshape(B, H, n, L, K)
        ks = kc.reshape(B, H, n, L, K)
        bs = b.reshape(B, H, n, L, K)
        gs = gc.reshape(B, H, n, L, K)
        bstart = bs[:, :, :, :1, :] - gs[:, :, :, :1, :]
        qf = qs * jnp.exp(bs - bstart)
        expo = bstart[:, :, :, None] - bs[:, :, None]
        kf = jnp.where(sub_mask, ks[:, :, None] * jnp.exp(jnp.where(sub_mask, expo, 0.0)), 0.0)
        a_off = jnp.einsum('bhjtk,bhjisk->bhjtis', qf, kf)
        diff = bs[:, :, :, :, None, :] - bs[:, :, :, None, :, :]
        wdec = jnp.where(causal, jnp.exp(jnp.where(causal, diff, 0.0)), 0.0)
        a_diag = jnp.einsum('bhjtk,bhjsk,bhjtsk->bhjts', qs, ks, wdec)
        a = (a_off + a_diag[:, :, :, :, None, :] * eye_n).reshape(B, H, C, C)
        o_intra = jnp.einsum('bhts,bhsv->bhtv', a, vc)
        b_last = b[:, :, -1:, :]
        new_state = (jnp.exp(b_last[:, :, 0, :])[..., None] * state
                     + jnp.einsum('bhsk,bhsv->bhkv', kc * jnp.exp(b_last - b), vc))
        return new_state, o_inter + o_intra

    state0 = jnp.zeros((B, H, K, V), dtype=jnp.float32)
    _, o = lax.scan(step, state0, (to_chunks(q), to_chunks(k), to_chunks(v), to_chunks(log_f)))
    return o.transpose(1, 0, 3, 2, 4).reshape(B, S, H, V)


def _hgrn2_mixer(h, w_in, lb, out_norm, w_out):
    B, S, _ = h.shape
    proj = h @ w_in
    zq, zf, zi, zg = jnp.split(proj, [HG_FDIM, 2 * HG_FDIM, 2 * HG_FDIM + HG_VDIM], axis=-1)
    q = jax.nn.silu(zq.astype(jnp.float32))
    zf = zf.astype(jnp.float32)
    log_lb = jnp.log(jnp.maximum(lb, LB_FLOOR))
    log_f = jnp.logaddexp(log_lb, jnp.log1p(-lb) + jax.nn.log_sigmoid(zf))
    k = (1.0 - lb) * jax.nn.sigmoid(-zf)
    v = zi.astype(jnp.float32)
    heads = lambda t, d: t.reshape(B, S, HG_HEADS, d)
    o = _hgrn2_chunkwise(heads(q, HG_EXPAND), heads(k, HG_EXPAND),
                         heads(v, HG_HEAD_V), heads(log_f, HG_EXPAND))
    o = _rmsnorm(o, out_norm) * jax.nn.silu(heads(zg.astype(jnp.float32), HG_HEAD_V))
    return o.reshape(B, S, HG_VDIM).astype(h.dtype) @ w_out


def _chunk_gmlp_mixer(h, w_in, ln_g, ln_b, w_s, b_s, w_out):
    B, S, _ = h.shape
    z = jax.nn.gelu(h @ w_in, approximate=False)
    u, v = jnp.split(z, 2, axis=-1)
    v = _layernorm(v, ln_g, ln_b)
    v = v.reshape(B, S // GM_CHUNK, GM_CHUNK, GM_GROUPS, GM_GROUP_DIM)
    ws = w_s * jnp.tril(jnp.ones((GM_CHUNK, GM_CHUNK), dtype=w_s.dtype))
    sv = jnp.einsum('gts,bnsgc->bntgc', ws, v) + b_s.T[None, None, :, :, None]
    y = u * sv.reshape(B, S, GM_WIDTH)
    return y @ w_out


def _swiglu(h, w_gate, w_up, w_down):
    return (jax.nn.silu(h @ w_gate) * (h @ w_up)) @ w_down


def setup_inputs(seed: int = 0) -> dict:
    key = jax.random.key(seed)
    ks = jax.random.split(key, 24)
    f32 = jnp.float32
    nrm = lambda k, shape, s: (jax.random.normal(k, shape, f32) * s).astype(f32)
    gain = lambda k, shape: 1.0 + nrm(k, shape, 0.02)
    D = D_MODEL
    return {
        "x": nrm(ks[0], (BATCH, SEQ, D), 1.0),
        "p": nrm(ks[1], (DEPTH, BATCH, SEQ, PLE_DIM), 1.0),
        "hg_w_in": nrm(ks[2], (N_A_LAYERS, D, 2 * HG_FDIM + 2 * HG_VDIM), D ** -0.5),
        "hg_lb_logits": nrm(ks[3], (N_A_LAYERS, HG_FDIM), 0.5),
        "hg_out_norm": gain(ks[4], (N_A_LAYERS, HG_HEAD_V)),
        "hg_w_out": nrm(ks[5], (N_A_LAYERS, HG_VDIM, D), HG_VDIM ** -0.5),
        "gm_w_in": nrm(ks[6], (N_B_LAYERS, D, 2 * GM_WIDTH), D ** -0.5),
        "gm_ln_g": gain(ks[7], (N_B_LAYERS, GM_WIDTH)),
        "gm_ln_b": nrm(ks[8], (N_B_LAYERS, GM_WIDTH), 0.02),
        "gm_w_s": nrm(ks[9], (N_B_LAYERS, GM_GROUPS, GM_CHUNK, GM_CHUNK), GM_CHUNK ** -0.5),
        "gm_b_s": 1.0 + nrm(ks[10], (N_B_LAYERS, GM_GROUPS, GM_CHUNK), 0.1),
        "gm_w_out": nrm(ks[11], (N_B_LAYERS, GM_WIDTH, D), GM_WIDTH ** -0.5),
        "norm_mix_pre": gain(ks[12], (DEPTH, D)),
        "norm_mix_post": gain(ks[13], (DEPTH, D)),
        "norm_ffn_pre": gain(ks[14], (DEPTH, D)),
        "norm_ffn_post": gain(ks[15], (DEPTH, D)),
        "ffn_w_gate": nrm(ks[16], (DEPTH, D, FFN_HIDDEN), D ** -0.5),
        "ffn_w_up": nrm(ks[17], (DEPTH, D, FFN_HIDDEN), D ** -0.5),
        "ffn_w_down": nrm(ks[18], (DEPTH, FFN_HIDDEN, D), FFN_HIDDEN ** -0.5),
        "ple_w_proj": nrm(ks[19], (DEPTH, PLE_DIM, D), PLE_DIM ** -0.5),
        "ple_w_gate": nrm(ks[20], (DEPTH, D, D), D ** -0.5),
        "ple_norm": gain(ks[21], (DEPTH, D)),
    }


def reference(x, p, hg_w_in, hg_lb_logits, hg_out_norm, hg_w_out, gm_w_in, gm_ln_g, gm_ln_b,
              gm_w_s, gm_b_s, gm_w_out, norm_mix_pre, norm_mix_post, norm_ffn_pre, norm_ffn_post,
              ffn_w_gate, ffn_w_up, ffn_w_down, ple_w_proj, ple_w_gate, ple_norm):
    lbs = _hgrn_lower_bounds(hg_lb_logits)
    h = x
    for i in range(DEPTH):
        j = i // N_MIXERS
        a = _rmsnorm(h, norm_mix_pre[i])
        if i % N_MIXERS == 0:
            m = _hgrn2_mixer(a, hg_w_in[j], lbs[j], hg_out_norm[j], hg_w_out[j])
        else:
            m = _chunk_gmlp_mixer(a, gm_w_in[j], gm_ln_g[j], gm_ln_b[j], gm_w_s[j], gm_b_s[j],
                                  gm_w_out[j])
        h = h + _rmsnorm(m, norm_mix_post[i])
        f = _swiglu(_rmsnorm(h, norm_ffn_pre[i]), ffn_w_gate[i], ffn_w_up[i], ffn_w_down[i])
        h = h + _rmsnorm(f, norm_ffn_post[i])
        e = p[i].astype(h.dtype) @ ple_w_proj[i]
        gate = jax.nn.sigmoid(h @ ple_w_gate[i])
        h = h + _rmsnorm(e * gate, ple_norm[i])
    return h
```

```cpp
#include <hip/hip_runtime.h>
#include <cstdio>
#include <cstdint>
namespace pg8 {
#define PG8_LAS __attribute__((address_space(3)))
typedef unsigned short bf16_t;
typedef short bf16x8 __attribute__((ext_vector_type(8)));
typedef float f32x4 __attribute__((ext_vector_type(4)));
typedef unsigned u32x4 __attribute__((ext_vector_type(4)));
constexpr int BM = 256, BK = 64, HALF = 128, HTB = HALF * BK * 2  , STAGE_BYTES = 8 * HTB, NXCD = 8, WGM = 8;

__host__ __device__ __forceinline__ int lds_byte(int r, int c) { const int st = (r >> 4) * 2 + (c >> 5), rr = r & 15, cc = c & 31, ob = rr * 64 + cc * 2; return st * 1024 + (ob ^ (((ob >> 9) & 1) << 5)); }
__host__ __device__ __forceinline__ void stage_rc(int b, int& R, int& C) { const int st = b / 1024, sb = b % 1024, swz = sb ^ (((sb >> 9) & 1) << 5); R = (st >> 1) * 16 + swz / 64; C = (st & 1) * 32 + (swz % 64) / 2; }
__host__ __device__ __forceinline__ int perm32(int rho) { const int n = rho >> 4, i = rho & 15; return 8 * (i >> 2) + 4 * n + (i & 3); }

struct Unit { int pm, pn; };
struct Gemm { const bf16_t* A; const bf16_t* Bt; int M, N, K; };

struct StaticOrder {
    int nM, nN, nwg, G, c;
    __host__ __device__ void init(int M, int N, int G_, int c_) { nM = M / BM; nN = N / BM; nwg = nM * nN; G = G_; c = c_; }
    __host__ __device__ bool next(int i, Unit& u) const {
        const long L = (long)i * G + c; if (L >= nwg) return false;
        int wgid = (int)L; { const int q = nwg / NXCD, r = nwg % NXCD, xcd = wgid % NXCD, off = wgid / NXCD; wgid = (xcd < r ? xcd * (q + 1) : r * (q + 1) + (xcd - r) * q) + off; }
        const int nig = WGM * nN, gid = wgid / nig, fm = gid * WGM, gsz = (nM - fm) < WGM ? (nM - fm) : WGM;
        u.pm = fm + ((wgid % nig) % gsz); u.pn = (wgid % nig) / gsz; return true;
    }
    __device__ __forceinline__ void a_ready(const Unit&) const {}
    __device__ __forceinline__ void done(const Unit&) const {}
};


__device__ __forceinline__ unsigned cvt_pk_bf16(float lo, float hi) { unsigned r; asm volatile("v_cvt_pk_bf16_f32 %0, %1, %2" : "=v"(r) : "v"(lo), "v"(hi)); return r; }
typedef float f32x2 __attribute__((ext_vector_type(2)));
__device__ __forceinline__ f32x2 gelu_pk(f32x2 v) {
    const f32x2 av = __builtin_elementwise_abs(v), d = av * 0.2316418882f + 1.0f;
    f32x2 t; t.x = __builtin_amdgcn_rcpf(d.x); t.y = __builtin_amdgcn_rcpf(d.y);
    f32x2 q = t * 0.5307027145f + (-0.7265760135f); q = q * t + 0.7107068705f; q = q * t + (-0.142248368f); q = q * t + 0.127414796f; q = q * t;
    const f32x2 s = (v * v) * (-0.72134752044f);
    f32x2 e; e.x = __builtin_amdgcn_exp2f(s.x); e.y = __builtin_amdgcn_exp2f(s.y);
    const f32x2 m = v * (q * e), r = v - m;
    f32x2 o; o.x = v.x < 0.f ? m.x : r.x; o.y = v.y < 0.f ? m.y : r.y; return o;
}
__device__ __forceinline__ float sigmoid_f(float x) { return __builtin_amdgcn_rcpf(1.0f + __builtin_amdgcn_exp2f(-1.4426950408889634f * x)); }
__device__ __forceinline__ float silu_f(float x) { return x * sigmoid_f(x); }

struct EpiF32 {
    static constexpr bool PERM = false, AFTER_DRAIN = false;
    float* C; int ldc;
    __device__ __forceinline__ void operator()(const f32x4 (&acc)[2][2][4][2], const Unit& u, int wr, int wc, int fr, int fq) const {
        const int row0 = u.pm * BM + wr * 64 + fr, col0 = u.pn * BM + wc * 32 + 4 * fq;
#pragma unroll
        for (int ai = 0; ai < 2; ++ai)
#pragma unroll
            for (int m = 0; m < 4; ++m) { float* rowp = C + (size_t)(row0 + ai * HALF + m * 16) * ldc + col0;
#pragma unroll
                for (int bj = 0; bj < 2; ++bj)
#pragma unroll
                    for (int n = 0; n < 2; ++n) *(f32x4*)(rowp + bj * HALF + n * 16) = acc[ai][bj][m][n]; }
    }
};
struct EpiGateMul {
    static constexpr bool PERM = false, AFTER_DRAIN = false;
    float* C; int ldc;
    __device__ __forceinline__ void operator()(const f32x4 (&acc)[2][2][4][2], const Unit& u, int wr, int wc, int fr, int fq) const {
        const int row0 = u.pm * BM + wr * 64 + fr, col0 = u.pn * BM + wc * 32 + 4 * fq;
#pragma unroll
        for (int ai = 0; ai < 2; ++ai)
#pragma unroll
            for (int m = 0; m < 4; ++m) { float* rowp = C + (size_t)(row0 + ai * HALF + m * 16) * ldc + col0;
#pragma unroll
                for (int bj = 0; bj < 2; ++bj)
#pragma unroll
                    for (int n = 0; n < 2; ++n) { f32x4 e = *(const f32x4*)(rowp + bj * HALF + n * 16); const f32x4 a = acc[ai][bj][m][n];
                        e[0] *= sigmoid_f(a[0]); e[1] *= sigmoid_f(a[1]); e[2] *= sigmoid_f(a[2]); e[3] *= sigmoid_f(a[3]);
                        *(f32x4*)(rowp + bj * HALF + n * 16) = e; } }
    }
};
template <int ACT> struct EpiBf16 {
    static constexpr bool PERM = true, AFTER_DRAIN = false;
    bf16_t* O; int ldc;
    __device__ __forceinline__ void operator()(const f32x4 (&acc)[2][2][4][2], const Unit& u, int wr, int wc, int fr, int fq) const {
        const int row0 = u.pm * BM + wr * 64 + fr, col0 = u.pn * BM + wc * 32 + 8 * fq;
#pragma unroll
        for (int ai = 0; ai < 2; ++ai)
#pragma unroll
            for (int m = 0; m < 4; ++m) { bf16_t* rowp = O + (size_t)(row0 + ai * HALF + m * 16) * ldc + col0;
#pragma unroll
                for (int bj = 0; bj < 2; ++bj) { f32x4 v0 = acc[ai][bj][m][0], v1 = acc[ai][bj][m][1];
                    if (ACT == 1) { f32x2 a = gelu_pk((f32x2){v0[0], v0[1]}), b = gelu_pk((f32x2){v0[2], v0[3]}), c = gelu_pk((f32x2){v1[0], v1[1]}), d = gelu_pk((f32x2){v1[2], v1[3]});
                        v0 = (f32x4){a.x, a.y, b.x, b.y}; v1 = (f32x4){c.x, c.y, d.x, d.y}; }
                    u32x4 w; w.x = cvt_pk_bf16(v0[0], v0[1]); w.y = cvt_pk_bf16(v0[2], v0[3]); w.z = cvt_pk_bf16(v1[0], v1[1]); w.w = cvt_pk_bf16(v1[2], v1[3]);
                    *(u32x4*)(rowp + bj * HALF) = w; } }
    }
};
struct EpiSwiGLU {
    static constexpr bool PERM = true, AFTER_DRAIN = false;
    bf16_t* O; int ldc;
    __device__ __forceinline__ void operator()(const f32x4 (&acc)[2][2][4][2], const Unit& u, int wr, int wc, int fr, int fq) const {
        const int row0 = u.pm * BM + wr * 64 + fr, col0 = u.pn * HALF + wc * 32 + 8 * fq;
#pragma unroll
        for (int ai = 0; ai < 2; ++ai)
#pragma unroll
            for (int m = 0; m < 4; ++m) { bf16_t* rowp = O + (size_t)(row0 + ai * HALF + m * 16) * ldc + col0;
                const f32x4 g0 = acc[ai][0][m][0], g1 = acc[ai][0][m][1], u0 = acc[ai][1][m][0], u1 = acc[ai][1][m][1];
                u32x4 w; w.x = cvt_pk_bf16(silu_f(g0[0]) * u0[0], silu_f(g0[1]) * u0[1]); w.y = cvt_pk_bf16(silu_f(g0[2]) * u0[2], silu_f(g0[3]) * u0[3]);
                w.z = cvt_pk_bf16(silu_f(g1[0]) * u1[0], silu_f(g1[1]) * u1[1]); w.w = cvt_pk_bf16(silu_f(g1[2]) * u1[2], silu_f(g1[3]) * u1[3]);
                *(u32x4*)rowp = w; }
    }
};

template <class Epi, class Sched, bool ALIGN_EPI = false, bool SP2 = false>
__device__ __forceinline__ void gemm_phase(PG8_LAS unsigned char* lds, const Gemm g, const Sched& S, const Epi& E) {
    int tid_ = threadIdx.x; asm volatile("" : "+v"(tid_));
    const int tid = tid_, wid = __builtin_amdgcn_readfirstlane(tid >> 6), lane = tid & 63, wr = wid >> 2, wc = wid & 3, fr = lane & 15, fq = lane >> 4;
    const int K = g.K, nt = K / BK;
    unsigned voffA[2], voffB[2];
#pragma unroll
    for (int i = 0; i < 2; ++i) { int R, C; stage_rc(tid * 16 + i * 8192, R, C); const int Rb = Epi::PERM ? ((R & ~31) + perm32(R & 31)) : R;
        voffA[i] = (unsigned)(R * K + C) * 2u; voffB[i] = (unsigned)(Rb * K + C) * 2u; }
    const size_t kstep = (size_t)(BK * 2);
    const size_t hstep = (size_t)HALF * K * 2;
    const size_t tstep = 2 * hstep;
    const unsigned ldsw = (unsigned)wid * 1024u;
    const int aoff = lds_byte(wr * 64 + fr, fq * 8), boff = lds_byte(wc * 32 + fr, fq * 8);
#define PG8_SA(b, h) (((b) * 2 + (h)) * HTB)
#define PG8_SB(b, h) ((4 + (b) * 2 + (h)) * HTB)
#define PG8_STAGE(bufoff, gbase, voff) do { _Pragma("unroll") for (int _i = 0; _i < 2; ++_i) \
        __builtin_amdgcn_global_load_lds((const unsigned*)((const char*)(gbase) + (voff)[_i]), (PG8_LAS unsigned*)(lds + (bufoff) + ldsw + _i * 8192), 16, 0, 0); } while (0)
#define PG8_LDA(dst, b, h) do { _Pragma("unroll") for (int m = 0; m < 4; ++m) _Pragma("unroll") for (int k = 0; k < 2; ++k) dst[m][k] = *(const PG8_LAS bf16x8*)(lds + PG8_SA(b, h) + aoff + m * 2048 + k * 1024); } while (0)
#define PG8_LDB(dst, b, h) do { _Pragma("unroll") for (int n = 0; n < 2; ++n) _Pragma("unroll") for (int k = 0; k < 2; ++k) dst[n][k] = *(const PG8_LAS bf16x8*)(lds + PG8_SB(b, h) + boff + n * 2048 + k * 1024); } while (0)
#define PG8_MMA(ai, bj, At, Bt) do { __builtin_amdgcn_s_setprio(1); _Pragma("unroll") for (int m = 0; m < 4; ++m) _Pragma("unroll") for (int n = 0; n < 2; ++n) _Pragma("unroll") for (int k = 0; k < 2; ++k) \
        acc[ai][bj][m][n] = __builtin_amdgcn_mfma_f32_16x16x32_bf16(Bt[n][k], At[m][k], acc[ai][bj][m][n], 0, 0, 0); __builtin_amdgcn_s_setprio(0); } while (0)
#define PG8_WAIT_V(n) asm volatile("s_waitcnt vmcnt(" #n ")" ::: "memory")
#define PG8_WAIT_L(n) asm volatile("s_waitcnt lgkmcnt(" #n ")" ::: "memory")
#define PG8_BAR __builtin_amdgcn_s_barrier()
#define PG8_SCHED __builtin_amdgcn_sched_barrier(0)
    Unit cur, nxt; int ui = 0;
    if (!S.next(0, cur)) return;
    f32x4 acc[2][2][4][2];
#pragma unroll
    for (int a = 0; a < 2; ++a)
#pragma unroll
        for (int b = 0; b < 2; ++b)
#pragma unroll
            for (int m = 0; m < 4; ++m)
#pragma unroll
                for (int n = 0; n < 2; ++n) acc[a][b][m][n] = (f32x4){0.f, 0.f, 0.f, 0.f};
    bf16x8 At[4][2], B0[2][2], B1[2][2];
    const char* cA = (const char*)g.A + (size_t)cur.pm * tstep; const char* cB = (const char*)g.Bt + (size_t)cur.pn * tstep;
    S.a_ready(cur);
    if constexpr (SP2) {
        PG8_STAGE(PG8_SB(0, 0), cB, voffB); PG8_STAGE(PG8_SB(0, 1), cB + hstep, voffB); PG8_STAGE(PG8_SA(0, 0), cA, voffA); PG8_STAGE(PG8_SA(0, 1), cA + hstep, voffA);
        if (wr == 1) PG8_BAR;
        PG8_WAIT_V(2); PG8_BAR;
        PG8_STAGE(PG8_SB(1, 0), cB + kstep, voffB); PG8_STAGE(PG8_SA(1, 0), cA + kstep, voffA); PG8_STAGE(PG8_SB(1, 1), cB + hstep + kstep, voffB);
        PG8_WAIT_V(6); PG8_BAR;
    } else {
        PG8_STAGE(PG8_SB(0, 0), cB, voffB); PG8_STAGE(PG8_SA(0, 0), cA, voffA); PG8_STAGE(PG8_SB(0, 1), cB + hstep, voffB); PG8_STAGE(PG8_SA(0, 1), cA + hstep, voffA);
        if (wr == 1) PG8_BAR;
        PG8_WAIT_V(4); PG8_BAR;
        PG8_STAGE(PG8_SB(1, 0), cB + kstep, voffB); PG8_STAGE(PG8_SA(1, 0), cA + kstep, voffA); PG8_STAGE(PG8_SB(1, 1), cB + hstep + kstep, voffB);
        PG8_WAIT_V(6); PG8_BAR;
    }
    for (;;) {
        const bool has_next = S.next(ui + 1, nxt);
        const char* nA = has_next ? (const char*)g.A + (size_t)nxt.pm * tstep : cA; const char* nB = has_next ? (const char*)g.Bt + (size_t)nxt.pn * tstep : cB;
        for (int t = 0; t < nt; t += 2) {
            const bool last = (t == nt - 2);
            const char* a1 = cA + (size_t)(t + 1) * kstep;
            const char* a2 = last ? nA : cA + (size_t)(t + 2) * kstep; const char* b2 = last ? nB : cB + (size_t)(t + 2) * kstep;
            const char* a3 = a2 + kstep; const char* b3 = b2 + kstep;
            if (last && has_next) S.a_ready(nxt);
            if constexpr (SP2) {
            PG8_LDB(B0, 0, 0); PG8_LDB(B1, 0, 1); PG8_SCHED; PG8_LDA(At, 0, 0); PG8_STAGE(PG8_SA(1, 1), a1 + hstep, voffA);
            PG8_WAIT_V(8); PG8_WAIT_L(0); PG8_BAR; PG8_MMA(0, 0, At, B0); PG8_MMA(0, 1, At, B1); PG8_BAR; PG8_SCHED;
            PG8_LDA(At, 0, 1); PG8_STAGE(PG8_SB(0, 0), b2, voffB); PG8_STAGE(PG8_SB(0, 1), b2 + hstep, voffB); PG8_STAGE(PG8_SA(0, 0), a2, voffA);
            PG8_WAIT_V(8); PG8_WAIT_L(0); PG8_BAR; PG8_MMA(1, 0, At, B0); PG8_MMA(1, 1, At, B1); PG8_BAR; PG8_SCHED;
            PG8_LDB(B0, 1, 0); PG8_LDB(B1, 1, 1); PG8_SCHED; PG8_LDA(At, 1, 0); PG8_STAGE(PG8_SA(0, 1), a2 + hstep, voffA);
            PG8_WAIT_V(8); PG8_WAIT_L(0); PG8_BAR; PG8_MMA(0, 0, At, B0); PG8_MMA(0, 1, At, B1); PG8_BAR; PG8_SCHED;
            PG8_LDA(At, 1, 1); PG8_STAGE(PG8_SB(1, 0), b3, voffB); PG8_STAGE(PG8_SB(1, 1), b3 + hstep, voffB); PG8_STAGE(PG8_SA(1, 0), a3, voffA);
            PG8_WAIT_V(8); PG8_WAIT_L(0); PG8_BAR; PG8_MMA(1, 0, At, B0); PG8_MMA(1, 1, At, B1); PG8_BAR; PG8_SCHED;
            } else {
            PG8_LDB(B0, 0, 0); PG8_SCHED; PG8_LDA(At, 0, 0); PG8_STAGE(PG8_SA(1, 1), a1 + hstep, voffA);
            PG8_WAIT_L(8); PG8_BAR; PG8_WAIT_L(0); PG8_MMA(0, 0, At, B0); PG8_BAR; PG8_SCHED;
            PG8_LDB(B1, 0, 1); PG8_STAGE(PG8_SB(0, 0), b2, voffB);
            PG8_BAR; PG8_WAIT_L(0); PG8_MMA(0, 1, At, B1); PG8_BAR;
            PG8_LDA(At, 0, 1); PG8_STAGE(PG8_SA(0, 0), a2, voffA);
            PG8_BAR; PG8_WAIT_L(0); PG8_MMA(1, 0, At, B0); PG8_BAR; PG8_SCHED;
            PG8_STAGE(PG8_SB(0, 1), b2 + hstep, voffB);
            PG8_WAIT_V(6); PG8_BAR; PG8_MMA(1, 1, At, B1); PG8_BAR;
            PG8_LDB(B0, 1, 0); PG8_SCHED; PG8_LDA(At, 1, 0); PG8_STAGE(PG8_SA(0, 1), a2 + hstep, voffA);
            PG8_WAIT_L(8); PG8_BAR; PG8_WAIT_L(0); PG8_MMA(0, 0, At, B0); PG8_BAR; PG8_SCHED;
            PG8_LDB(B1, 1, 1); PG8_STAGE(PG8_SB(1, 0), b3, voffB);
            PG8_BAR; PG8_WAIT_L(0); PG8_MMA(0, 1, At, B1); PG8_BAR;
            PG8_LDA(At, 1, 1); PG8_STAGE(PG8_SA(1, 0), a3, voffA);
            PG8_BAR; PG8_WAIT_L(0); PG8_MMA(1, 0, At, B0); PG8_BAR; PG8_SCHED;
            PG8_STAGE(PG8_SB(1, 1), b3 + hstep, voffB);
            PG8_WAIT_V(6); PG8_BAR; PG8_MMA(1, 1, At, B1); PG8_BAR;
            }
        }
        if constexpr (ALIGN_EPI) { if (wr == 0) PG8_BAR; }
        if constexpr (!Epi::AFTER_DRAIN) { E(acc, cur, wr, wc, fr, fq); S.done(cur); }
        if (!has_next) break;
#pragma unroll
        for (int a = 0; a < 2; ++a)
#pragma unroll
            for (int b = 0; b < 2; ++b)
#pragma unroll
                for (int m = 0; m < 4; ++m)
#pragma unroll
                    for (int n = 0; n < 2; ++n) acc[a][b][m][n] = (f32x4){0.f, 0.f, 0.f, 0.f};
        cur = nxt; cA = nA; cB = nB; ++ui;
        if constexpr (ALIGN_EPI) { if (wr == 1) PG8_BAR; }
    }
    PG8_WAIT_V(0);
    if constexpr (!ALIGN_EPI) { if (wr == 0) PG8_BAR; }
    PG8_BAR;
    if constexpr (Epi::AFTER_DRAIN) { E.fused(acc, cur, wr, wc, fr, fq, lds, wid, lane); S.done(cur); }
#undef PG8_SA
#undef PG8_SB
#undef PG8_STAGE
#undef PG8_LDA
#undef PG8_LDB
#undef PG8_MMA
#undef PG8_WAIT_V
#undef PG8_WAIT_L
#undef PG8_BAR
#undef PG8_SCHED
}
}
#define GAS __attribute__((address_space(1)))
#define LAS __attribute__((address_space(3)))
typedef unsigned short bf16;
typedef unsigned v4u __attribute__((ext_vector_type(4)));
typedef float f32x4 __attribute__((ext_vector_type(4)));
typedef short bf16x8 __attribute__((ext_vector_type(8)));
typedef GAS unsigned gu32;
typedef GAS unsigned long long gu64;
#define RLX_AGENT __ATOMIC_RELAXED, __HIP_MEMORY_SCOPE_AGENT
#define LDS_WAIT() asm volatile("s_waitcnt lgkmcnt(0)" ::: "memory")
#define VM_WAIT() asm volatile("s_waitcnt vmcnt(0)" ::: "memory")
__device__ __forceinline__ unsigned long long rt() { return __builtin_amdgcn_s_memrealtime(); }
__device__ __forceinline__ unsigned f2bf(float f) { unsigned u = __builtin_bit_cast(unsigned, f); return (u + 0x7fffu + ((u >> 16) & 1u)) >> 16; }
__device__ __forceinline__ unsigned pk2(float lo, float hi) { return f2bf(lo) | (f2bf(hi) << 16); }

#define XB_TMO      128
#define XB_XCNT(j)  (256  + 64 * (j))
#define XB_XSUB(j)  (1280 + 64 * (j))
#define XB_XGEN(j)  (2304 + 64 * (j))
#define XB_TOP      3328
#define XB_TOPGEN   3392
#define XCD_BAR_WORDS 3456
#define XB_SPIN_CAP (1u << 18)

__device__ __forceinline__ unsigned xb_ld(unsigned* p)              { return __hip_atomic_load(p, __ATOMIC_RELAXED, __HIP_MEMORY_SCOPE_AGENT); }
__device__ __forceinline__ unsigned xb_add(unsigned* p, unsigned v) { return __hip_atomic_fetch_add(p, v, __ATOMIC_RELAXED, __HIP_MEMORY_SCOPE_AGENT); }
__device__ __forceinline__ unsigned xb_xcc_id() { return (unsigned)__builtin_amdgcn_s_getreg((3 << 11) | 20) & 0xFu; }
#define XB_SPIN(cond, bar) do { unsigned _sp = 0; while (cond) { __builtin_amdgcn_s_sleep(1); \
    if ((++_sp & 255u) == 0u) { if (xb_ld(&(bar)[XB_TMO])) break; if (_sp > XB_SPIN_CAP) { atomicAdd(&(bar)[XB_TMO], 1u); break; } } } } while (0)

struct XcdBarrier {
    unsigned* bar; unsigned x;
    volatile LAS unsigned* st;
};

__device__ __forceinline__ XcdBarrier xcd_barrier_post(unsigned* bar, volatile LAS unsigned* st) {
    XcdBarrier b; b.bar = bar; b.x = xb_xcc_id(); b.st = st;
    if (threadIdx.x == 0) (void)xb_add(&bar[XB_XCNT(b.x)], 1u);
    return b;
}
__device__ __forceinline__ void xcd_barrier_complete(unsigned* bar, unsigned x, unsigned& nloc, unsigned& nx) {
    const unsigned G = gridDim.x * gridDim.y * gridDim.z;
    unsigned sum, cnt, mine, sp = 0u;
    for (;;) {
        sum = 0u; cnt = 0u; mine = 0u;
#pragma unroll
        for (unsigned j = 0; j < 16; ++j) { const unsigned c = xb_ld(&bar[XB_XCNT(j)]); sum += c; cnt += (c > 0u) ? 1u : 0u; mine = (j == x) ? c : mine; }
        if (sum == G) break;
        __builtin_amdgcn_s_sleep(1);
        if ((++sp & 255u) == 0u) { if (xb_ld(&bar[XB_TMO])) break; if (sp > XB_SPIN_CAP) { atomicAdd(&bar[XB_TMO], 1u); break; } }
    }
    nloc = mine > 0u ? mine : 1u; nx = cnt > 0u ? cnt : 1u;
}

__device__ __forceinline__ void xcd_barrier(const XcdBarrier& b) {
    asm volatile("s_waitcnt vmcnt(0)" ::: "memory");
    __syncthreads();
    if (threadIdx.x == 0) {
        unsigned* bar = b.bar;
        __builtin_amdgcn_s_waitcnt(0);
        unsigned nloc = b.st[0], nx = b.st[1];
        if (nloc == 0u) { xcd_barrier_complete(bar, b.x, nloc, nx); b.st[0] = nloc; b.st[1] = nx; }
        const unsigned old = xb_add(&bar[XB_XSUB(b.x)], 1u);
        const unsigned gen = old / nloc;
        if (old + 1u == (gen + 1u) * nloc) {
            __builtin_amdgcn_fence(__ATOMIC_RELEASE, "agent");
            asm volatile("s_waitcnt vmcnt(0)" ::: "memory");
            const unsigned og = xb_add(&bar[XB_TOP], 1u);
            const unsigned tg = og / nx;
            if (og + 1u == (tg + 1u) * nx) xb_add(&bar[XB_TOPGEN], 1u);
            else XB_SPIN(xb_ld(&bar[XB_TOPGEN]) == tg, bar);
            __builtin_amdgcn_fence(__ATOMIC_ACQUIRE, "agent");
            xb_add(&bar[XB_XGEN(b.x)], 1u);
            asm volatile("s_waitcnt vmcnt(0)" ::: "memory");
        } else {
            XB_SPIN(xb_ld(&bar[XB_XGEN(b.x)]) == gen, bar);
            __builtin_amdgcn_fence(__ATOMIC_ACQUIRE, "agent");
            asm volatile("s_waitcnt vmcnt(0)" ::: "memory");
        }
    }
    __syncthreads();
}


constexpr int NWAVES = 8;
constexpr int BATCH = 16, SEQ = 2048, D = 2048, DEPTH = 4, M = BATCH * SEQ;
constexpr int HG_PROJ = 8192, HG_HEADS = 16, HG_K = 128;
constexpr int GM_PROJ = 4096, GM_G = 16, GM_C = 128;
constexpr int FF = 5632, PLE = 256;
constexpr float EPS = 1e-6f;
constexpr int NPHASE = 1 + 9 * DEPTH;

#ifndef DIS_GMLP
#define DIS_GMLP 0
#endif
#ifndef DIS_HGRN
#define DIS_HGRN 0
#endif
#ifndef DIS_THIN
#define DIS_THIN 0
#endif
#ifndef NLOOP
#define NLOOP DEPTH
#endif
#ifndef EN_MASK
#define EN_MASK 0xff
#endif
#define EN(n) (((EN_MASK) >> (n)) & 1)
#ifndef MK_ONE_LAUNCH
#define MK_ONE_LAUNCH 0
#endif

constexpr size_t MiB = 1u << 20;
constexpr size_t WS_CTL = 0, CTL_ZERO_BYTES = 65536;
constexpr size_t WS_W1 = 1 * MiB;
constexpr size_t WS_W2 = 33 * MiB;
constexpr size_t WS_WGU = 41 * MiB;
constexpr size_t WS_WD = 85 * MiB;
constexpr size_t WS_WPG = 107 * MiB;
constexpr size_t WS_WPP = 115 * MiB;
constexpr size_t WS_PB = 116 * MiB;
constexpr size_t WS_WST = 132 * MiB;
constexpr size_t WS_A = 134 * MiB;
constexpr size_t WS_BIG = 262 * MiB;
constexpr size_t WS_MO = 774 * MiB;
constexpr size_t WS_END = 1030 * MiB;
constexpr int CW_BAR = 4096;

constexpr int RING_OFF = 0, RING_BYTES = 131072;
constexpr int LDSCTL_OFF = RING_BYTES, MISC_OFF = LDSCTL_OFF + 320, XTRA_OFF = LDSCTL_OFF + 1024;
constexpr int LDS_BYTES = 147456;

typedef unsigned v2u __attribute__((ext_vector_type(2)));
__device__ __forceinline__ float wave_sum(float v) {
#pragma unroll
    for (int o = 1; o < 64; o <<= 1) v += __shfl_xor(v, o);
    return v;
}
__device__ __forceinline__ float dot4(f32x4 a) { return (a.x * a.x + a.y * a.y) + (a.z * a.z + a.w * a.w); }
__device__ __forceinline__ float bf2f(unsigned short b) { return __builtin_bit_cast(float, ((unsigned)b) << 16); }
__device__ __forceinline__ float bfw(unsigned w, int hi) { return __builtin_bit_cast(float, hi ? (w & 0xffff0000u) : (w << 16)); }
__device__ __forceinline__ float sigm(float x) { return 1.0f / (1.0f + __expf(-x)); }

__device__ __forceinline__ void transpose_item(const float* W, int K, int N, bf16* WT, int mode, LAS float* scr, int item, int lane) {
    const int nblk = N / 32, kb = item / nblk, nb = item % nblk, k0 = 64 * kb, n0 = 32 * nb;
    const int d0 = mode == 0 ? n0 : ((n0 >> 7) * 256 + (n0 & 127) + (mode == 2 ? 128 : 0));
#pragma unroll 8
    for (int i = 0; i < 32; ++i) { const int kk = 2 * i + (lane >> 5); scr[kk * 33 + (lane & 31)] = W[(size_t)(k0 + kk) * N + n0 + (lane & 31)]; }
    LDS_WAIT(); asm volatile("" ::: "memory");
    const int c = lane & 7;
#pragma unroll
    for (int j = 0; j < 4; ++j) { const int n = (lane >> 3) + 8 * j; const LAS float* s = scr + (8 * c) * 33 + n;
        v4u o; o.x = pk2(s[0 * 33], s[1 * 33]); o.y = pk2(s[2 * 33], s[3 * 33]); o.z = pk2(s[4 * 33], s[5 * 33]); o.w = pk2(s[6 * 33], s[7 * 33]);
        *(GAS v4u*)(WT + (size_t)(d0 + n) * K + k0 + 8 * c) = o; }
    LDS_WAIT(); asm volatile("" ::: "memory");
}

struct In { const float* p[22]; };

__device__ __forceinline__ void convert_layer(const In& in, unsigned char* ws, int L, LAS unsigned char* lds, int gw, int NGW, int wave, int lane) {
    asm volatile("" : "+v"(lane));
    LAS float* scr = (LAS float*)(lds + RING_OFF + wave * 16384);
    const int j = L >> 1;
    const bool odd = (L & 1) != 0;
    const float* w1 = odd ? in.p[6] + (size_t)j * D * GM_PROJ : in.p[2] + (size_t)j * D * HG_PROJ;
    const int n1 = odd ? GM_PROJ : HG_PROJ;
    const float* w2 = odd ? in.p[11] + (size_t)j * D * D : in.p[5] + (size_t)j * D * D;
    const float* wg = in.p[16] + (size_t)L * D * FF; const float* wu = in.p[17] + (size_t)L * D * FF; const float* wd = in.p[18] + (size_t)L * FF * D;
    const float* wpp = in.p[19] + (size_t)L * PLE * D; const float* wpg = in.p[20] + (size_t)L * D * D;
    const int I1 = (D / 64) * (n1 / 32), I2 = (D / 64) * (D / 32), IG = (D / 64) * (FF / 32), ID = (FF / 64) * (D / 32), IPP = (PLE / 64) * (D / 32);
    const int NITEMS = I1 + I2 + 2 * IG + ID + I2 + IPP;
    for (int it = gw; it < NITEMS; it += NGW) {
        int r = it;
        if (r < I1) { transpose_item(w1, D, n1, (bf16*)(ws + WS_W1), 0, scr, r, lane); continue; } r -= I1;
        if (r < I2) { transpose_item(w2, D, D, (bf16*)(ws + WS_W2), 0, scr, r, lane); continue; } r -= I2;
        if (r < IG) { transpose_item(wg, D, FF, (bf16*)(ws + WS_WGU), 1, scr, r, lane); continue; } r -= IG;
        if (r < IG) { transpose_item(wu, D, FF, (bf16*)(ws + WS_WGU), 2, scr, r, lane); continue; } r -= IG;
        if (r < ID) { transpose_item(wd, FF, D, (bf16*)(ws + WS_WD), 0, scr, r, lane); continue; } r -= ID;
        if (r < I2) { transpose_item(wpg, D, D, (bf16*)(ws + WS_WPG), 0, scr, r, lane); continue; } r -= I2;
        transpose_item(wpp, PLE, D, (bf16*)(ws + WS_WPP), 0, scr, r, lane);
    }
    { const float* ps = in.p[1] + (size_t)L * M * PLE; bf16* pb = (bf16*)(ws + WS_PB);
      for (size_t i = (size_t)gw * 64 + lane; i < (size_t)M * PLE / 8; i += (size_t)NGW * 64) {
          const f32x4 a = *(const GAS f32x4*)(ps + i * 8), b = *(const GAS f32x4*)(ps + i * 8 + 4);
          v4u o; o.x = pk2(a.x, a.y); o.y = pk2(a.z, a.w); o.z = pk2(b.x, b.y); o.w = pk2(b.z, b.w);
          *(GAS v4u*)(pb + i * 8) = o; } }
    if (odd) {
        const float* wsrc = in.p[9] + (size_t)j * GM_G * GM_C * GM_C; float* wst = (float*)(ws + WS_WST);
        for (int i = gw * 64 + lane; i < GM_G * GM_C * GM_C; i += NGW * 64) { const int t = i & 127, s = (i >> 7) & 127, g = i >> 14;
            wst[i] = (s <= t) ? wsrc[(g * GM_C + t) * GM_C + s] : 0.f; }
    }
}

__device__ __forceinline__ void norm_rows_to_bf16(const float* x, const float* g, bf16* A, int gw, int NGW, int lane) {
    for (int m = gw; m < M; m += NGW) {
        const GAS f32x4* xr = (const GAS f32x4*)(x + (size_t)m * D) + lane;
        f32x4 v[8]; float ss = 0.f;
#pragma unroll
        for (int j = 0; j < 8; ++j) { v[j] = xr[64 * j]; ss += dot4(v[j]); }
        const float rstd = 1.0f / sqrtf(wave_sum(ss) * (1.f / D) + EPS);
        GAS unsigned long long* o8 = (GAS unsigned long long*)(A + (size_t)m * D) + lane;
#pragma unroll
        for (int j = 0; j < 8; ++j) { const f32x4 gg = ((const GAS f32x4*)g)[lane + 64 * j]; const f32x4 a = v[j] * rstd * gg;
            o8[64 * j] = (unsigned long long)pk2(a.x, a.y) | ((unsigned long long)pk2(a.z, a.w) << 32); }
    }
}
template <bool NORM_A, bool WRITE_A>
__device__ __forceinline__ void thin_phase(const float* hin, const float* mo, const float* gpost, const float* gnext, float* hout, bf16* A, int gw, int NGW, int lane) {
    asm volatile("" : "+v"(lane));
    for (int m = gw; m < M; m += NGW) {
        const GAS f32x4* hr = (const GAS f32x4*)(hin + (size_t)m * D) + lane; const GAS f32x4* mr = (const GAS f32x4*)(mo + (size_t)m * D) + lane;
        GAS f32x4* ho = (GAS f32x4*)(hout + (size_t)m * D) + lane;
        f32x4 hv[8], mv[8]; float ss = 0.f;
#pragma unroll
        for (int j = 0; j < 8; ++j) { mv[j] = mr[64 * j]; hv[j] = hr[64 * j]; ss += dot4(mv[j]); }
        const float rstd = 1.0f / sqrtf(wave_sum(ss) * (1.f / D) + EPS);
        float ss2 = 0.f;
#pragma unroll
        for (int j = 0; j < 8; ++j) { const f32x4 gg = ((const GAS f32x4*)gpost)[lane + 64 * j]; hv[j] = hv[j] + mv[j] * rstd * gg; ss2 += dot4(hv[j]); ho[64 * j] = hv[j]; }
        if (WRITE_A) {
            const float r2 = NORM_A ? 1.0f / sqrtf(wave_sum(ss2) * (1.f / D) + EPS) : 1.0f;
            GAS unsigned long long* o8 = (GAS unsigned long long*)(A + (size_t)m * D) + lane;
#pragma unroll
            for (int j = 0; j < 8; ++j) { f32x4 a = hv[j] * r2; if (NORM_A) a = a * ((const GAS f32x4*)gnext)[lane + 64 * j];
                o8[64 * j] = (unsigned long long)pk2(a.x, a.y) | ((unsigned long long)pk2(a.z, a.w) << 32); }
        }
    }
}

__device__ __forceinline__ void hgrn_naive_phase(const bf16* proj, const float* lb_logits, int j, const float* out_norm, bf16* Y, LAS unsigned char* lds, int tid, int G) {
    asm volatile("" : "+v"(tid));
    LAS float* Q = (LAS float*)(lds);
    LAS float* F = Q + 2048; LAS float* KK = F + 2048; LAS float* V = KK + 2048; LAS float* Gt = V + 2048;
    LAS float* Po = Gt + 2048;
    const int tok = tid >> 5, c4 = (tid & 31) * 4, v = tid & 127, kg = tid >> 7;
    for (int u = blockIdx.x; u < BATCH * HG_HEADS; u += G) {
        const int b = u / HG_HEADS, hd = u % HG_HEADS;
        float lb[4], lbf[4], onw[4];
#pragma unroll
        for (int i = 0; i < 4; ++i) { const int ch = hd * HG_K + c4 + i; const float l0 = lb_logits[ch], l1 = lb_logits[2048 + ch];
            lb[i] = (j == 0) ? 0.f : 1.0f / (1.0f + __expf(l0 - l1)); lbf[i] = fmaxf(lb[i], 1e-30f); onw[i] = out_norm[c4 + i]; }
        float S[32];
#pragma unroll
        for (int i = 0; i < 32; ++i) S[i] = 0.f;
        for (int t0 = 0; t0 < SEQ; t0 += 16) {
            { const size_t row = (size_t)b * SEQ + t0 + tok; const bf16* pr = proj + row * HG_PROJ + hd * HG_K + c4;
              const v2u zq = *(const GAS v2u*)(pr), zf = *(const GAS v2u*)(pr + 2048), zi = *(const GAS v2u*)(pr + 4096), zg = *(const GAS v2u*)(pr + 6144);
              const unsigned qw[2] = {zq.x, zq.y}, fw[2] = {zf.x, zf.y}, iw[2] = {zi.x, zi.y}, gw2[2] = {zg.x, zg.y};
              f32x4 qv, fv, kv, vv, gv;
#pragma unroll
              for (int i = 0; i < 4; ++i) { const float a = bfw(qw[i >> 1], i & 1); qv[i] = a * sigm(a); const float z = bfw(fw[i >> 1], i & 1); fv[i] = lbf[i] + (1.0f - lb[i]) * sigm(z); kv[i] = (1.0f - lb[i]) * sigm(-z); vv[i] = bfw(iw[i >> 1], i & 1); gv[i] = bfw(gw2[i >> 1], i & 1); }
              const int o = tok * 128 + c4;
              *(LAS f32x4*)(Q + o) = qv; *(LAS f32x4*)(F + o) = fv; *(LAS f32x4*)(KK + o) = kv; *(LAS f32x4*)(V + o) = vv; *(LAS f32x4*)(Gt + o) = gv; }
            __syncthreads();
            for (int t = 0; t < 16; ++t) {
                const float vt = V[t * 128 + v]; float po = 0.f;
#pragma unroll
                for (int i4 = 0; i4 < 8; ++i4) { const int o = t * 128 + kg * 32 + i4 * 4; const f32x4 f4 = *(const LAS f32x4*)(F + o), k4 = *(const LAS f32x4*)(KK + o), q4 = *(const LAS f32x4*)(Q + o);
#pragma unroll
                    for (int e = 0; e < 4; ++e) { S[i4 * 4 + e] = f4[e] * S[i4 * 4 + e] + k4[e] * vt; po += S[i4 * 4 + e] * q4[e]; } }
                Po[(t * 4 + kg) * 128 + v] = po;
            }
            __syncthreads();
            { f32x4 o4 = *(const LAS f32x4*)(Po + (tok * 4 + 0) * 128 + c4);
#pragma unroll
              for (int g2 = 1; g2 < 4; ++g2) o4 = o4 + *(const LAS f32x4*)(Po + (tok * 4 + g2) * 128 + c4);
              float ss = dot4(o4);
#pragma unroll
              for (int o = 1; o < 32; o <<= 1) ss += __shfl_xor(ss, o);
              const float rstd = 1.0f / sqrtf(ss * (1.f / 128.f) + EPS);
              const f32x4 gv = *(const LAS f32x4*)(Gt + tok * 128 + c4);
              float y[4];
#pragma unroll
              for (int i = 0; i < 4; ++i) y[i] = o4[i] * rstd * onw[i] * (gv[i] * sigm(gv[i]));
              const size_t row = (size_t)b * SEQ + t0 + tok;
              *(GAS unsigned long long*)(Y + row * D + hd * HG_K + c4) = (unsigned long long)pk2(y[0], y[1]) | ((unsigned long long)pk2(y[2], y[3]) << 32); }
            __syncthreads();
        }
    }
}

__device__ __forceinline__ void gmlp_naive_phase(const bf16* z, const float* ln_g, const float* ln_b, const float* wst, const float* b_s, bf16* Y, LAS unsigned char* lds, int tid, int G) {
    asm volatile("" : "+v"(tid));
    LAS float* Vn = (LAS float*)(lds);
    LAS float* WT = Vn + 16384;
    LAS float* ST = (LAS float*)(lds + XTRA_OFF);
    const int lane = tid & 63, wave = tid >> 6;
    for (int u = blockIdx.x; u < BATCH * (SEQ / GM_C); u += G) {
        const size_t row0 = (size_t)u * GM_C;
        for (int r = wave * 16; r < wave * 16 + 16; ++r) {
            const bf16* vr = z + (row0 + r) * GM_PROJ + 2048 + lane * 8;
            float x[32]; float s = 0.f;
#pragma unroll
            for (int jj = 0; jj < 4; ++jj) { const v4u w = *(const GAS v4u*)(vr + 512 * jj); const unsigned ww[4] = {w.x, w.y, w.z, w.w};
#pragma unroll
                for (int e = 0; e < 4; ++e) { x[jj * 8 + 2 * e] = __builtin_bit_cast(float, ww[e] << 16); x[jj * 8 + 2 * e + 1] = __builtin_bit_cast(float, ww[e] & 0xffff0000u); s += x[jj * 8 + 2 * e] + x[jj * 8 + 2 * e + 1]; } }
            const float mean = wave_sum(s) * (1.f / 2048.f); float q = 0.f;
#pragma unroll
            for (int e = 0; e < 32; ++e) { const float d = x[e] - mean; q += d * d; }
            const float rstd = 1.0f / sqrtf(wave_sum(q) * (1.f / 2048.f) + EPS);
            if (lane == 0) { ST[2 * r] = mean; ST[2 * r + 1] = rstd; }
        }
        __syncthreads();
        for (int g = 0; g < GM_G; ++g) {
#pragma unroll
            for (int i = 0; i < 4; ++i) { const int s = (tid >> 4) + 32 * i, c8 = (tid & 15) * 8;
                const v4u w = *(const GAS v4u*)(z + (row0 + s) * GM_PROJ + 2048 + g * GM_C + c8); const unsigned ww[4] = {w.x, w.y, w.z, w.w};
                const float mean = ST[2 * s], rstd = ST[2 * s + 1];
                const f32x4 g0 = *(const GAS f32x4*)(ln_g + g * GM_C + c8), g1 = *(const GAS f32x4*)(ln_g + g * GM_C + c8 + 4), b0 = *(const GAS f32x4*)(ln_b + g * GM_C + c8), b1 = *(const GAS f32x4*)(ln_b + g * GM_C + c8 + 4);
                f32x4 o0, o1;
                o0.x = (__builtin_bit_cast(float, ww[0] << 16) - mean) * rstd * g0.x + b0.x; o0.y = (__builtin_bit_cast(float, ww[0] & 0xffff0000u) - mean) * rstd * g0.y + b0.y;
                o0.z = (__builtin_bit_cast(float, ww[1] << 16) - mean) * rstd * g0.z + b0.z; o0.w = (__builtin_bit_cast(float, ww[1] & 0xffff0000u) - mean) * rstd * g0.w + b0.w;
                o1.x = (__builtin_bit_cast(float, ww[2] << 16) - mean) * rstd * g1.x + b1.x; o1.y = (__builtin_bit_cast(float, ww[2] & 0xffff0000u) - mean) * rstd * g1.y + b1.y;
                o1.z = (__builtin_bit_cast(float, ww[3] << 16) - mean) * rstd * g1.z + b1.z; o1.w = (__builtin_bit_cast(float, ww[3] & 0xffff0000u) - mean) * rstd * g1.w + b1.w;
                *(LAS f32x4*)(Vn + s * 128 + c8) = o0; *(LAS f32x4*)(Vn + s * 128 + c8 + 4) = o1; }
#pragma unroll
            for (int i = 0; i < 8; ++i) { const int e4 = tid + 512 * i; *(LAS f32x4*)(WT + e4 * 4) = *(const GAS f32x4*)(wst + (size_t)g * 16384 + e4 * 4); }
            __syncthreads();
            { int tid2 = tid; asm volatile("" : "+v"(tid2)); const int c = tid2 & 127, tq = tid2 >> 7; float acc[32];
#pragma unroll
              for (int i = 0; i < 32; ++i) acc[i] = 0.f;
              const int smax = tq * 32 + 32;
              for (int s = 0; s < smax; ++s) { const float vn = Vn[s * 128 + c];
#pragma unroll
                  for (int i4 = 0; i4 < 8; ++i4) { const f32x4 w4 = *(const LAS f32x4*)(WT + s * 128 + tq * 32 + i4 * 4);
#pragma unroll
                      for (int e = 0; e < 4; ++e) acc[i4 * 4 + e] += w4[e] * vn; } }
#pragma unroll
              for (int i = 0; i < 32; ++i) { const int t = tq * 32 + i; const size_t row = row0 + t;
                  const float uu = bf2f(z[row * GM_PROJ + g * GM_C + c]); const float yv = uu * (acc[i] + b_s[g * GM_C + t]);
                  Y[row * D + g * GM_C + c] = (bf16)f2bf(yv); } }
            __syncthreads();
        }
    }
}

struct Args { In in; float* out; unsigned char* ws; int ph_lo, ph_hi; };
__global__ void __launch_bounds__(NWAVES * 64, 2) fwd(Args args) {
    extern __shared__ __attribute__((aligned(16))) unsigned char lds_raw[];
    LAS unsigned char* lds = (LAS unsigned char*)lds_raw;
    volatile LAS unsigned* MISC = (volatile LAS unsigned*)(lds + MISC_OFF);
    const int tid = threadIdx.x, lane = tid & 63, wave = __builtin_amdgcn_readfirstlane(tid >> 6);
    const int G = gridDim.x; const int bx = blockIdx.x; const int vcu = (G % 8 == 0) ? (bx % 8) * (G / 8) + bx / 8 : bx;
    const int gw = vcu * NWAVES + wave, NGW = G * NWAVES;
    unsigned char* ws = args.ws; gu32* ctl = (gu32*)(ws + WS_CTL);
    for (int u = tid; u < (LDS_BYTES - LDSCTL_OFF) / 4; u += NWAVES * 64) ((LAS unsigned*)(lds + LDSCTL_OFF))[u] = 0u;
    __syncthreads();
    XcdBarrier bar; bar.bar = (unsigned*)(ctl + CW_BAR); bar.x = 0; bar.st = nullptr;
    if (MK_ONE_LAUNCH) bar = xcd_barrier_post((unsigned*)(ctl + CW_BAR), MISC + 8);
    const int lo = args.ph_lo, hi = args.ph_hi;
#define IN(k) (lo <= (k) && (k) < hi)
#define SEAM(k) do { if (IN(k) && IN((k) + 1)) xcd_barrier(bar); } while (0)
    const In& in = args.in;
    bf16* const A = (bf16*)(ws + WS_A); bf16* const BIG = (bf16*)(ws + WS_BIG); float* const MO = (float*)(ws + WS_MO);
    float* const out = args.out;

    if (!DIS_THIN && IN(0)) { convert_layer(in, ws, 0, lds, gw, NGW, wave, lane); norm_rows_to_bf16(in.p[0], in.p[12], A, gw, NGW, lane); }
    SEAM(0);

    for (int L = 0; L < NLOOP; ++L) {
        const int pb = 1 + 9 * L, j = L >> 1;
        if (L & 1) {
            if (EN(0) && IN(pb)) { pg8::Gemm g{A, (const bf16*)(ws + WS_W1), M, GM_PROJ, D}; pg8::StaticOrder S; S.init(M, GM_PROJ, G, bx);
                pg8::EpiBf16<1> E{BIG, GM_PROJ}; pg8::gemm_phase<pg8::EpiBf16<1>, pg8::StaticOrder, true, true>(lds + RING_OFF, g, S, E); }
            SEAM(pb);
            if (!DIS_GMLP && IN(pb + 1)) gmlp_naive_phase(BIG, in.p[7] + j * 2048, in.p[8] + j * 2048, (const float*)(ws + WS_WST), in.p[10] + j * GM_G * GM_C, A, lds, tid, G);
            SEAM(pb + 1);
        } else {
            if (EN(1) && IN(pb)) { pg8::Gemm g{A, (const bf16*)(ws + WS_W1), M, HG_PROJ, D}; pg8::StaticOrder S; S.init(M, HG_PROJ, G, bx);
                pg8::EpiBf16<0> E{BIG, HG_PROJ}; pg8::gemm_phase<pg8::EpiBf16<0>, pg8::StaticOrder, true, true>(lds + RING_OFF, g, S, E); }
            SEAM(pb);
            if (!DIS_HGRN && IN(pb + 1)) hgrn_naive_phase(BIG, in.p[3], j, in.p[4] + j * HG_K, A, lds, tid, G);
            SEAM(pb + 1);
        }
        if (EN(2) && IN(pb + 2)) { pg8::Gemm g{A, (const bf16*)(ws + WS_W2), M, D, D}; pg8::StaticOrder S; S.init(M, D, G, bx);
            pg8::EpiF32 E{MO, D}; pg8::gemm_phase<pg8::EpiF32, pg8::StaticOrder, true, true>(lds + RING_OFF, g, S, E); }
        SEAM(pb + 2);
        if (!DIS_THIN && IN(pb + 3)) thin_phase<true, true>(L == 0 ? in.p[0] : out, MO, in.p[13] + L * D, in.p[14] + L * D, out, A, gw, NGW, lane);
        SEAM(pb + 3);
        if (EN(3) && IN(pb + 4)) { pg8::Gemm g{A, (const bf16*)(ws + WS_WGU), M, 2 * FF, D}; pg8::StaticOrder S; S.init(M, 2 * FF, G, bx);
            pg8::EpiSwiGLU E{BIG, FF}; pg8::gemm_phase<pg8::EpiSwiGLU, pg8::StaticOrder, true, true>(lds + RING_OFF, g, S, E); }
        SEAM(pb + 4);
        if (EN(4) && IN(pb + 5)) { pg8::Gemm g{BIG, (const bf16*)(ws + WS_WD), M, D, FF}; pg8::StaticOrder S; S.init(M, D, G, bx);
            pg8::EpiF32 E{MO, D}; pg8::gemm_phase<pg8::EpiF32, pg8::StaticOrder, true, true>(lds + RING_OFF, g, S, E); }
        SEAM(pb + 5);
        if (!DIS_THIN && IN(pb + 6)) thin_phase<false, true>(out, MO, in.p[15] + L * D, nullptr, out, A, gw, NGW, lane);
        SEAM(pb + 6);
        if (IN(pb + 7)) {
            if (EN(5)) { pg8::Gemm g{(const bf16*)(ws + WS_PB), (const bf16*)(ws + WS_WPP), M, D, PLE}; pg8::StaticOrder S; S.init(M, D, G, bx);
              pg8::EpiF32 E{MO, D}; pg8::gemm_phase<pg8::EpiF32, pg8::StaticOrder, true, true>(lds + RING_OFF, g, S, E); }
            __syncthreads();
            if (EN(6)) { pg8::Gemm g{A, (const bf16*)(ws + WS_WPG), M, D, D}; pg8::StaticOrder S; S.init(M, D, G, bx);
              pg8::EpiGateMul E{MO, D}; pg8::gemm_phase<pg8::EpiGateMul, pg8::StaticOrder, true, true>(lds + RING_OFF, g, S, E); }
        }
        SEAM(pb + 7);
        if (!DIS_THIN && IN(pb + 8)) {
            if (L + 1 < DEPTH) { thin_phase<true, true>(out, MO, in.p[21] + L * D, in.p[12] + (L + 1) * D, out, A, gw, NGW, lane); __syncthreads(); convert_layer(in, ws, L + 1, lds, gw, NGW, wave, lane); }
            else thin_phase<false, false>(out, MO, in.p[21] + L * D, nullptr, out, nullptr, gw, NGW, lane);
        }
        SEAM(pb + 8);
    }
#undef IN
#undef SEAM
}

extern "C" void kernel_launch(void* const* d_in, const int* in_sizes, int n_in, void* d_out, int out_size, void* d_ws, size_t ws_size, hipStream_t stream) {
    static int grid = 0;
    if (grid == 0) {
        if (n_in != 22 || out_size != M * D || ws_size < WS_END) { fprintf(stderr, "kernel_launch: unexpected shapes: n_in %d out %d ws %zu (need %zu)\n", n_in, out_size, ws_size, (size_t)WS_END); grid = -1; return; }
        int dev = 0, cus = 0, per_cu = 0;
        if (hipGetDevice(&dev) != hipSuccess || hipDeviceGetAttribute(&cus, hipDeviceAttributeMultiprocessorCount, dev) != hipSuccess) { grid = -1; return; }
        if (hipFuncSetAttribute((const void*)fwd, hipFuncAttributeMaxDynamicSharedMemorySize, LDS_BYTES) != hipSuccess) { fprintf(stderr, "kernel_launch: hipFuncSetAttribute failed\n"); grid = -1; return; }
        if (hipOccupancyMaxActiveBlocksPerMultiprocessor(&per_cu, (const void*)fwd, NWAVES * 64, LDS_BYTES) != hipSuccess || per_cu < 1) fprintf(stderr, "kernel_launch: occupancy query says %d\n", per_cu);
        (void)hipGetLastError();
        grid = cus;
    }
    if (grid < 0) return;
    (void)hipMemsetAsync((char*)d_ws + WS_CTL, 0, CTL_ZERO_BYTES, stream);
    Args a{};
    for (int i = 0; i < 22; ++i) a.in.p[i] = (const float*)d_in[i];
    a.out = (float*)d_out; a.ws = (unsigned char*)d_ws;
#if MK_ONE_LAUNCH
    a.ph_lo = 0; a.ph_hi = NPHASE;
    hipLaunchKernelGGL(fwd, dim3(grid), dim3(NWAVES * 64), LDS_BYTES, stream, a);
#else
    for (int p = 0; p < NPHASE; ++p) { a.ph_lo = p; a.ph_hi = p + 1; hipLaunchKernelGGL(fwd, dim3(grid), dim3(NWAVES * 64), LDS_BYTES, stream, a); }
#endif
}
```

```cpp
#include <hip/hip_runtime.h>
#include <cstdio>
#include <cstdint>
#ifndef PG_WGM
#define PG_WGM 4
#endif
namespace pg8 {
#define PG8_LAS __attribute__((address_space(3)))
typedef unsigned short bf16_t;
typedef short bf16x8 __attribute__((ext_vector_type(8)));
typedef float f32x4 __attribute__((ext_vector_type(4)));
typedef unsigned u32x4 __attribute__((ext_vector_type(4)));
constexpr int BM = 256, BK = 64, HALF = 128, HTB = HALF * BK * 2  , STAGE_BYTES = 8 * HTB, NXCD = 8, WGM = PG_WGM;

__host__ __device__ __forceinline__ int lds_byte(int r, int c) { const int st = (r >> 4) * 2 + (c >> 5), rr = r & 15, cc = c & 31, ob = rr * 64 + cc * 2; return st * 1024 + (ob ^ (((ob >> 9) & 1) << 5)); }
__host__ __device__ __forceinline__ void stage_rc(int b, int& R, int& C) { const int st = b / 1024, sb = b % 1024, swz = sb ^ (((sb >> 9) & 1) << 5); R = (st >> 1) * 16 + swz / 64; C = (st & 1) * 32 + (swz % 64) / 2; }
__host__ __device__ __forceinline__ int perm32(int rho) { const int n = rho >> 4, i = rho & 15; return 8 * (i >> 2) + 4 * n + (i & 3); }

struct Unit { int pm, pn; };
struct Gemm { const bf16_t* A; const bf16_t* Bt; int M, N, K; };

struct StaticOrder {
    int nM, nN, nwg, G, c;
    __host__ __device__ void init(int M, int N, int G_, int c_) { nM = M / BM; nN = N / BM; nwg = nM * nN; G = G_; c = c_; }
    __host__ __device__ bool next(int i, Unit& u) const {
        const long L = (long)i * G + c; if (L >= nwg) return false;
        int wgid = (int)L; { const int q = nwg / NXCD, r = nwg % NXCD, xcd = wgid % NXCD, off = wgid / NXCD; wgid = (xcd < r ? xcd * (q + 1) : r * (q + 1) + (xcd - r) * q) + off; }
        const int nig = WGM * nN, gid = wgid / nig, fm = gid * WGM, gsz = (nM - fm) < WGM ? (nM - fm) : WGM;
        u.pm = fm + ((wgid % nig) % gsz); u.pn = (wgid % nig) / gsz; return true;
    }
    __device__ __forceinline__ void a_ready(const Unit&) const {}
    __device__ __forceinline__ void done(const Unit&) const {}
};


__device__ __forceinline__ unsigned cvt_pk_bf16(float lo, float hi) { unsigned r; asm volatile("v_cvt_pk_bf16_f32 %0, %1, %2" : "=v"(r) : "v"(lo), "v"(hi)); return r; }
typedef float f32x2 __attribute__((ext_vector_type(2)));
#ifndef NT_STORE
#define NT_STORE 0
#endif
__device__ __forceinline__ f32x2 gelu_pk(f32x2 v) {
    const f32x2 av = __builtin_elementwise_abs(v), d = av * 0.2316418882f + 1.0f;
    f32x2 t; t.x = __builtin_amdgcn_rcpf(d.x); t.y = __builtin_amdgcn_rcpf(d.y);
    f32x2 q = t * 0.5307027145f + (-0.7265760135f); q = q * t + 0.7107068705f; q = q * t + (-0.142248368f); q = q * t + 0.127414796f; q = q * t;
    const f32x2 s = (v * v) * (-0.72134752044f);
    f32x2 e; e.x = __builtin_amdgcn_exp2f(s.x); e.y = __builtin_amdgcn_exp2f(s.y);
    const f32x2 m = v * (q * e), r = v - m;
    f32x2 o; o.x = v.x < 0.f ? m.x : r.x; o.y = v.y < 0.f ? m.y : r.y; return o;
}
__device__ __forceinline__ float sigmoid_f(float x) { return __builtin_amdgcn_rcpf(1.0f + __builtin_amdgcn_exp2f(-1.4426950408889634f * x)); }
__device__ __forceinline__ float silu_f(float x) { return x * sigmoid_f(x); }

struct EpiF32 {
    static constexpr bool PERM = false, AFTER_DRAIN = false;
    float* C; int ldc;
    __device__ __forceinline__ void operator()(const f32x4 (&acc)[2][2][4][2], const Unit& u, int wr, int wc, int fr, int fq) const {
        const int row0 = u.pm * BM + wr * 64 + fr, col0 = u.pn * BM + wc * 32 + 4 * fq;
#pragma unroll
        for (int ai = 0; ai < 2; ++ai)
#pragma unroll
            for (int m = 0; m < 4; ++m) { float* rowp = C + (size_t)(row0 + ai * HALF + m * 16) * ldc + col0;
#pragma unroll
                for (int bj = 0; bj < 2; ++bj)
#pragma unroll
                    for (int n = 0; n < 2; ++n) *(f32x4*)(rowp + bj * HALF + n * 16) = acc[ai][bj][m][n]; }
    }
};
struct EpiGateMul {
    static constexpr bool PERM = false, AFTER_DRAIN = false;
    float* C; int ldc;
    __device__ __forceinline__ void operator()(const f32x4 (&acc)[2][2][4][2], const Unit& u, int wr, int wc, int fr, int fq) const {
        const int row0 = u.pm * BM + wr * 64 + fr, col0 = u.pn * BM + wc * 32 + 4 * fq;
#pragma unroll
        for (int ai = 0; ai < 2; ++ai)
#pragma unroll
            for (int m = 0; m < 4; ++m) { float* rowp = C + (size_t)(row0 + ai * HALF + m * 16) * ldc + col0;
#pragma unroll
                for (int bj = 0; bj < 2; ++bj)
#pragma unroll
                    for (int n = 0; n < 2; ++n) { f32x4 e = *(const f32x4*)(rowp + bj * HALF + n * 16); const f32x4 a = acc[ai][bj][m][n];
                        e[0] *= sigmoid_f(a[0]); e[1] *= sigmoid_f(a[1]); e[2] *= sigmoid_f(a[2]); e[3] *= sigmoid_f(a[3]);
                        *(f32x4*)(rowp + bj * HALF + n * 16) = e; } }
    }
};
template <int ACT> struct EpiBf16 {
    static constexpr bool PERM = true, AFTER_DRAIN = false;
    bf16_t* O; int ldc; int nt;
    __device__ __forceinline__ void operator()(const f32x4 (&acc)[2][2][4][2], const Unit& u, int wr, int wc, int fr, int fq) const {
        const int row0 = u.pm * BM + wr * 64 + fr, col0 = u.pn * BM + wc * 32 + 8 * fq;
#pragma unroll
        for (int ai = 0; ai < 2; ++ai)
#pragma unroll
            for (int m = 0; m < 4; ++m) { bf16_t* rowp = O + (size_t)(row0 + ai * HALF + m * 16) * ldc + col0;
#pragma unroll
                for (int bj = 0; bj < 2; ++bj) { f32x4 v0 = acc[ai][bj][m][0], v1 = acc[ai][bj][m][1];
                    if (ACT == 1) { f32x2 a = gelu_pk((f32x2){v0[0], v0[1]}), b = gelu_pk((f32x2){v0[2], v0[3]}), c = gelu_pk((f32x2){v1[0], v1[1]}), d = gelu_pk((f32x2){v1[2], v1[3]});
                        v0 = (f32x4){a.x, a.y, b.x, b.y}; v1 = (f32x4){c.x, c.y, d.x, d.y}; }
                    u32x4 w; w.x = cvt_pk_bf16(v0[0], v0[1]); w.y = cvt_pk_bf16(v0[2], v0[3]); w.z = cvt_pk_bf16(v1[0], v1[1]); w.w = cvt_pk_bf16(v1[2], v1[3]);
                    if (nt) __builtin_nontemporal_store(w, (u32x4*)(rowp + bj * HALF)); else *(u32x4*)(rowp + bj * HALF) = w; } }
    }
};

struct EpiGateMulBf16 {
    static constexpr bool PERM = true, AFTER_DRAIN = false;
    bf16_t* O; int ldc;
    __device__ __forceinline__ void operator()(const f32x4 (&acc)[2][2][4][2], const Unit& u, int wr, int wc, int fr, int fq) const {
        const int row0 = u.pm * BM + wr * 64 + fr, col0 = u.pn * BM + wc * 32 + 8 * fq;
#pragma unroll
        for (int ai = 0; ai < 2; ++ai)
#pragma unroll
            for (int m = 0; m < 4; ++m) { bf16_t* rowp = O + (size_t)(row0 + ai * HALF + m * 16) * ldc + col0;
#pragma unroll
                for (int bj = 0; bj < 2; ++bj) { const u32x4 ev = *(const u32x4*)(rowp + bj * HALF); const f32x4 v0 = acc[ai][bj][m][0], v1 = acc[ai][bj][m][1];
                    const unsigned e0 = ev.x, e1 = ev.y, e2 = ev.z, e3 = ev.w;
                    u32x4 w;
                    w.x = cvt_pk_bf16(__builtin_bit_cast(float, e0 << 16) * sigmoid_f(v0[0]), __builtin_bit_cast(float, e0 & 0xffff0000u) * sigmoid_f(v0[1]));
                    w.y = cvt_pk_bf16(__builtin_bit_cast(float, e1 << 16) * sigmoid_f(v0[2]), __builtin_bit_cast(float, e1 & 0xffff0000u) * sigmoid_f(v0[3]));
                    w.z = cvt_pk_bf16(__builtin_bit_cast(float, e2 << 16) * sigmoid_f(v1[0]), __builtin_bit_cast(float, e2 & 0xffff0000u) * sigmoid_f(v1[1]));
                    w.w = cvt_pk_bf16(__builtin_bit_cast(float, e3 << 16) * sigmoid_f(v1[2]), __builtin_bit_cast(float, e3 & 0xffff0000u) * sigmoid_f(v1[3]));
                    *(u32x4*)(rowp + bj * HALF) = w; } }
    }
};
struct EpiSwiGLU {
    static constexpr bool PERM = true, AFTER_DRAIN = false;
    bf16_t* O; int ldc;
    __device__ __forceinline__ void operator()(const f32x4 (&acc)[2][2][4][2], const Unit& u, int wr, int wc, int fr, int fq) const {
        const int row0 = u.pm * BM + wr * 64 + fr, col0 = u.pn * HALF + wc * 32 + 8 * fq;
#pragma unroll
        for (int ai = 0; ai < 2; ++ai)
#pragma unroll
            for (int m = 0; m < 4; ++m) { bf16_t* rowp = O + (size_t)(row0 + ai * HALF + m * 16) * ldc + col0;
                const f32x4 g0 = acc[ai][0][m][0], g1 = acc[ai][0][m][1], u0 = acc[ai][1][m][0], u1 = acc[ai][1][m][1];
                u32x4 w; w.x = cvt_pk_bf16(silu_f(g0[0]) * u0[0], silu_f(g0[1]) * u0[1]); w.y = cvt_pk_bf16(silu_f(g0[2]) * u0[2], silu_f(g0[3]) * u0[3]);
                w.z = cvt_pk_bf16(silu_f(g1[0]) * u1[0], silu_f(g1[1]) * u1[1]); w.w = cvt_pk_bf16(silu_f(g1[2]) * u1[2], silu_f(g1[3]) * u1[3]);
                if (NT_STORE) __builtin_nontemporal_store(w, (u32x4*)rowp); else *(u32x4*)rowp = w; }
    }
};

template <class Epi, class Sched, bool ALIGN_EPI = false, bool SP2 = false, bool NOEPI = false>
__device__ __forceinline__ void gemm_phase(PG8_LAS unsigned char* lds, const Gemm g, const Sched& S, const Epi& E) {
    int tid_ = threadIdx.x; asm volatile("" : "+v"(tid_));
    const int tid = tid_, wid = __builtin_amdgcn_readfirstlane(tid >> 6), lane = tid & 63, wr = wid >> 2, wc = wid & 3, fr = lane & 15, fq = lane >> 4;
    const int K = g.K, nt = K / BK;
    unsigned voffA[2], voffB[2];
#pragma unroll
    for (int i = 0; i < 2; ++i) { int R, C; stage_rc(tid * 16 + i * 8192, R, C); const int Rb = Epi::PERM ? ((R & ~31) + perm32(R & 31)) : R;
        voffA[i] = (unsigned)(R * K + C) * 2u; voffB[i] = (unsigned)(Rb * K + C) * 2u; }
    const size_t kstep = (size_t)(BK * 2);
    const size_t hstep = (size_t)HALF * K * 2;
    const size_t tstep = 2 * hstep;
    const unsigned ldsw = (unsigned)wid * 1024u;
    const int aoff = lds_byte(wr * 64 + fr, fq * 8), boff = lds_byte(wc * 32 + fr, fq * 8);
#define PG8_SA(b, h) (((b) * 2 + (h)) * HTB)
#define PG8_SB(b, h) ((4 + (b) * 2 + (h)) * HTB)
#define PG8_STAGE(bufoff, gbase, voff) do { _Pragma("unroll") for (int _i = 0; _i < 2; ++_i) \
        __builtin_amdgcn_global_load_lds((const unsigned*)((const char*)(gbase) + (voff)[_i]), (PG8_LAS unsigned*)(lds + (bufoff) + ldsw + _i * 8192), 16, 0, 0); } while (0)
#define PG8_LDA(dst, b, h) do { _Pragma("unroll") for (int m = 0; m < 4; ++m) _Pragma("unroll") for (int k = 0; k < 2; ++k) dst[m][k] = *(const PG8_LAS bf16x8*)(lds + PG8_SA(b, h) + aoff + m * 2048 + k * 1024); } while (0)
#define PG8_LDB(dst, b, h) do { _Pragma("unroll") for (int n = 0; n < 2; ++n) _Pragma("unroll") for (int k = 0; k < 2; ++k) dst[n][k] = *(const PG8_LAS bf16x8*)(lds + PG8_SB(b, h) + boff + n * 2048 + k * 1024); } while (0)
#define PG8_MMA(ai, bj, At, Bt) do { __builtin_amdgcn_s_setprio(1); _Pragma("unroll") for (int m = 0; m < 4; ++m) _Pragma("unroll") for (int n = 0; n < 2; ++n) _Pragma("unroll") for (int k = 0; k < 2; ++k) \
        acc[ai][bj][m][n] = __builtin_amdgcn_mfma_f32_16x16x32_bf16(Bt[n][k], At[m][k], acc[ai][bj][m][n], 0, 0, 0); __builtin_amdgcn_s_setprio(0); } while (0)
#define PG8_WAIT_V(n) asm volatile("s_waitcnt vmcnt(" #n ")" ::: "memory")
#define PG8_WAIT_L(n) asm volatile("s_waitcnt lgkmcnt(" #n ")" ::: "memory")
#define PG8_BAR __builtin_amdgcn_s_barrier()
#define PG8_SCHED __builtin_amdgcn_sched_barrier(0)
    Unit cur, nxt; int ui = 0;
    if (!S.next(0, cur)) return;
    f32x4 acc[2][2][4][2];
#pragma unroll
    for (int a = 0; a < 2; ++a)
#pragma unroll
        for (int b = 0; b < 2; ++b)
#pragma unroll
            for (int m = 0; m < 4; ++m)
#pragma unroll
                for (int n = 0; n < 2; ++n) acc[a][b][m][n] = (f32x4){0.f, 0.f, 0.f, 0.f};
    bf16x8 At[4][2], B0[2][2], B1[2][2];
    const char* cA = (const char*)g.A + (size_t)cur.pm * tstep; const char* cB = (const char*)g.Bt + (size_t)cur.pn * tstep;
    S.a_ready(cur);
    if constexpr (SP2) {
        PG8_STAGE(PG8_SB(0, 0), cB, voffB); PG8_STAGE(PG8_SB(0, 1), cB + hstep, voffB); PG8_STAGE(PG8_SA(0, 0), cA, voffA); PG8_STAGE(PG8_SA(0, 1), cA + hstep, voffA);
        if (wr == 1) PG8_BAR;
        PG8_WAIT_V(2); PG8_BAR;
        PG8_STAGE(PG8_SB(1, 0), cB + kstep, voffB); PG8_STAGE(PG8_SA(1, 0), cA + kstep, voffA); PG8_STAGE(PG8_SB(1, 1), cB + hstep + kstep, voffB);
        PG8_WAIT_V(6); PG8_BAR;
    } else {
        PG8_STAGE(PG8_SB(0, 0), cB, voffB); PG8_STAGE(PG8_SA(0, 0), cA, voffA); PG8_STAGE(PG8_SB(0, 1), cB + hstep, voffB); PG8_STAGE(PG8_SA(0, 1), cA + hstep, voffA);
        if (wr == 1) PG8_BAR;
        PG8_WAIT_V(4); PG8_BAR;
        PG8_STAGE(PG8_SB(1, 0), cB + kstep, voffB); PG8_STAGE(PG8_SA(1, 0), cA + kstep, voffA); PG8_STAGE(PG8_SB(1, 1), cB + hstep + kstep, voffB);
        PG8_WAIT_V(6); PG8_BAR;
    }
    for (;;) {
        const bool has_next = S.next(ui + 1, nxt);
        const char* nA = has_next ? (const char*)g.A + (size_t)nxt.pm * tstep : cA; const char* nB = has_next ? (const char*)g.Bt + (size_t)nxt.pn * tstep : cB;
        for (int t = 0; t < nt; t += 2) {
            const bool last = (t == nt - 2);
            const char* a1 = cA + (size_t)(t + 1) * kstep;
            const char* a2 = last ? nA : cA + (size_t)(t + 2) * kstep; const char* b2 = last ? nB : cB + (size_t)(t + 2) * kstep;
            const char* a3 = a2 + kstep; const char* b3 = b2 + kstep;
            if (last && has_next) S.a_ready(nxt);
            if constexpr (SP2) {
            PG8_LDB(B0, 0, 0); PG8_LDB(B1, 0, 1); PG8_SCHED; PG8_LDA(At, 0, 0); PG8_STAGE(PG8_SA(1, 1), a1 + hstep, voffA);
            PG8_WAIT_V(8); PG8_WAIT_L(0); PG8_BAR; PG8_MMA(0, 0, At, B0); PG8_MMA(0, 1, At, B1); PG8_BAR; PG8_SCHED;
            PG8_LDA(At, 0, 1); PG8_STAGE(PG8_SB(0, 0), b2, voffB); PG8_STAGE(PG8_SB(0, 1), b2 + hstep, voffB); PG8_STAGE(PG8_SA(0, 0), a2, voffA);
            PG8_WAIT_V(8); PG8_WAIT_L(0); PG8_BAR; PG8_MMA(1, 0, At, B0); PG8_MMA(1, 1, At, B1); PG8_BAR; PG8_SCHED;
            PG8_LDB(B0, 1, 0); PG8_LDB(B1, 1, 1); PG8_SCHED; PG8_LDA(At, 1, 0); PG8_STAGE(PG8_SA(0, 1), a2 + hstep, voffA);
            PG8_WAIT_V(8); PG8_WAIT_L(0); PG8_BAR; PG8_MMA(0, 0, At, B0); PG8_MMA(0, 1, At, B1); PG8_BAR; PG8_SCHED;
            PG8_LDA(At, 1, 1); PG8_STAGE(PG8_SB(1, 0), b3, voffB); PG8_STAGE(PG8_SB(1, 1), b3 + hstep, voffB); PG8_STAGE(PG8_SA(1, 0), a3, voffA);
            PG8_WAIT_V(8); PG8_WAIT_L(0); PG8_BAR; PG8_MMA(1, 0, At, B0); PG8_MMA(1, 1, At, B1); PG8_BAR; PG8_SCHED;
            } else {
            PG8_LDB(B0, 0, 0); PG8_SCHED; PG8_LDA(At, 0, 0); PG8_STAGE(PG8_SA(1, 1), a1 + hstep, voffA);
            PG8_WAIT_L(8); PG8_BAR; PG8_WAIT_L(0); PG8_MMA(0, 0, At, B0); PG8_BAR; PG8_SCHED;
            PG8_LDB(B1, 0, 1); PG8_STAGE(PG8_SB(0, 0), b2, voffB);
            PG8_BAR; PG8_WAIT_L(0); PG8_MMA(0, 1, At, B1); PG8_BAR;
            PG8_LDA(At, 0, 1); PG8_STAGE(PG8_SA(0, 0), a2, voffA);
            PG8_BAR; PG8_WAIT_L(0); PG8_MMA(1, 0, At, B0); PG8_BAR; PG8_SCHED;
            PG8_STAGE(PG8_SB(0, 1), b2 + hstep, voffB);
            PG8_WAIT_V(6); PG8_BAR; PG8_MMA(1, 1, At, B1); PG8_BAR;
            PG8_LDB(B0, 1, 0); PG8_SCHED; PG8_LDA(At, 1, 0); PG8_STAGE(PG8_SA(0, 1), a2 + hstep, voffA);
            PG8_WAIT_L(8); PG8_BAR; PG8_WAIT_L(0); PG8_MMA(0, 0, At, B0); PG8_BAR; PG8_SCHED;
            PG8_LDB(B1, 1, 1); PG8_STAGE(PG8_SB(1, 0), b3, voffB);
            PG8_BAR; PG8_WAIT_L(0); PG8_MMA(0, 1, At, B1); PG8_BAR;
            PG8_LDA(At, 1, 1); PG8_STAGE(PG8_SA(1, 0), a3, voffA);
            PG8_BAR; PG8_WAIT_L(0); PG8_MMA(1, 0, At, B0); PG8_BAR; PG8_SCHED;
            PG8_STAGE(PG8_SB(1, 1), b3 + hstep, voffB);
            PG8_WAIT_V(6); PG8_BAR; PG8_MMA(1, 1, At, B1); PG8_BAR;
            }
        }
        if constexpr (ALIGN_EPI) { if (wr == 0) PG8_BAR; }
        if constexpr (!Epi::AFTER_DRAIN && !NOEPI) { E(acc, cur, wr, wc, fr, fq); S.done(cur); }
        if constexpr (NOEPI) { f32x4 sacc = (f32x4){0.f, 0.f, 0.f, 0.f};
#pragma unroll
            for (int a = 0; a < 2; ++a)
#pragma unroll
                for (int bb = 0; bb < 2; ++bb)
#pragma unroll
                    for (int m = 0; m < 4; ++m)
#pragma unroll
                        for (int n = 0; n < 2; ++n) sacc += acc[a][bb][m][n];
            asm volatile("" :: "v"(sacc)); }
        if (!has_next) break;
#pragma unroll
        for (int a = 0; a < 2; ++a)
#pragma unroll
            for (int b = 0; b < 2; ++b)
#pragma unroll
                for (int m = 0; m < 4; ++m)
#pragma unroll
                    for (int n = 0; n < 2; ++n) acc[a][b][m][n] = (f32x4){0.f, 0.f, 0.f, 0.f};
        cur = nxt; cA = nA; cB = nB; ++ui;
        if constexpr (ALIGN_EPI) { if (wr == 1) PG8_BAR; }
    }
    PG8_WAIT_V(0);
    if constexpr (!ALIGN_EPI) { if (wr == 0) PG8_BAR; }
    PG8_BAR;
    if constexpr (Epi::AFTER_DRAIN) { E.fused(acc, cur, wr, wc, fr, fq, lds, wid, lane); S.done(cur); }
#undef PG8_SA
#undef PG8_SB
#undef PG8_STAGE
#undef PG8_LDA
#undef PG8_LDB
#undef PG8_MMA
#undef PG8_WAIT_V
#undef PG8_WAIT_L
#undef PG8_BAR
#undef PG8_SCHED
}
}
#define GAS __attribute__((address_space(1)))
#define LAS __attribute__((address_space(3)))
typedef unsigned short bf16;
typedef unsigned v4u __attribute__((ext_vector_type(4)));
typedef float f32x4 __attribute__((ext_vector_type(4)));
typedef short bf16x8 __attribute__((ext_vector_type(8)));
typedef GAS unsigned gu32;
typedef GAS unsigned long long gu64;
#define RLX_AGENT __ATOMIC_RELAXED, __HIP_MEMORY_SCOPE_AGENT
#define LDS_WAIT() asm volatile("s_waitcnt lgkmcnt(0)" ::: "memory")
#define VM_WAIT() asm volatile("s_waitcnt vmcnt(0)" ::: "memory")
__device__ __forceinline__ unsigned long long rt() { return __builtin_amdgcn_s_memrealtime(); }
__device__ __forceinline__ unsigned f2bf(float f) { unsigned u = __builtin_bit_cast(unsigned, f); return (u + 0x7fffu + ((u >> 16) & 1u)) >> 16; }
__device__ __forceinline__ unsigned pk2(float lo, float hi) { return f2bf(lo) | (f2bf(hi) << 16); }

#define XB_TMO      128
#define XB_XCNT(j)  (256  + 64 * (j))
#define XB_XSUB(j)  (1280 + 64 * (j))
#define XB_XGEN(j)  (2304 + 64 * (j))
#define XB_TOP      3328
#define XB_TOPGEN   3392
#define XCD_BAR_WORDS 3456
#define XB_SPIN_CAP (1u << 18)

__device__ __forceinline__ unsigned xb_ld(unsigned* p)              { return __hip_atomic_load(p, __ATOMIC_RELAXED, __HIP_MEMORY_SCOPE_AGENT); }
__device__ __forceinline__ unsigned xb_add(unsigned* p, unsigned v) { return __hip_atomic_fetch_add(p, v, __ATOMIC_RELAXED, __HIP_MEMORY_SCOPE_AGENT); }
__device__ __forceinline__ unsigned xb_xcc_id() { return (unsigned)__builtin_amdgcn_s_getreg((3 << 11) | 20) & 0xFu; }
#define XB_SPIN(cond, bar) do { unsigned _sp = 0; while (cond) { __builtin_amdgcn_s_sleep(1); \
    if ((++_sp & 255u) == 0u) { if (xb_ld(&(bar)[XB_TMO])) break; if (_sp > XB_SPIN_CAP) { atomicAdd(&(bar)[XB_TMO], 1u); break; } } } } while (0)

struct XcdBarrier {
    unsigned* bar; unsigned x;
    volatile LAS unsigned* st;
};

__device__ __forceinline__ XcdBarrier xcd_barrier_post(unsigned* bar, volatile LAS unsigned* st) {
    XcdBarrier b; b.bar = bar; b.x = xb_xcc_id(); b.st = st;
    if (threadIdx.x == 0) (void)xb_add(&bar[XB_XCNT(b.x)], 1u);
    return b;
}
__device__ __forceinline__ void xcd_barrier_complete(unsigned* bar, unsigned x, unsigned& nloc, unsigned& nx) {
    const unsigned G = gridDim.x * gridDim.y * gridDim.z;
    unsigned sum, cnt, mine, sp = 0u;
    for (;;) {
        sum = 0u; cnt = 0u; mine = 0u;
#pragma unroll
        for (unsigned j = 0; j < 16; ++j) { const unsigned c = xb_ld(&bar[XB_XCNT(j)]); sum += c; cnt += (c > 0u) ? 1u : 0u; mine = (j == x) ? c : mine; }
        if (sum == G) break;
        __builtin_amdgcn_s_sleep(1);
        if ((++sp & 255u) == 0u) { if (xb_ld(&bar[XB_TMO])) break; if (sp > XB_SPIN_CAP) { atomicAdd(&bar[XB_TMO], 1u); break; } }
    }
    nloc = mine > 0u ? mine : 1u; nx = cnt > 0u ? cnt : 1u;
}

__device__ __forceinline__ void xcd_barrier(const XcdBarrier& b) {
    asm volatile("s_waitcnt vmcnt(0)" ::: "memory");
    __syncthreads();
    if (threadIdx.x == 0) {
        unsigned* bar = b.bar;
        __builtin_amdgcn_s_waitcnt(0);
        unsigned nloc = b.st[0], nx = b.st[1];
        if (nloc == 0u) { xcd_barrier_complete(bar, b.x, nloc, nx); b.st[0] = nloc; b.st[1] = nx; }
        const unsigned old = xb_add(&bar[XB_XSUB(b.x)], 1u);
        const unsigned gen = old / nloc;
        if (old + 1u == (gen + 1u) * nloc) {
            __builtin_amdgcn_fence(__ATOMIC_RELEASE, "agent");
            asm volatile("s_waitcnt vmcnt(0)" ::: "memory");
            const unsigned og = xb_add(&bar[XB_TOP], 1u);
            const unsigned tg = og / nx;
            if (og + 1u == (tg + 1u) * nx) xb_add(&bar[XB_TOPGEN], 1u);
            else XB_SPIN(xb_ld(&bar[XB_TOPGEN]) == tg, bar);
            __builtin_amdgcn_fence(__ATOMIC_ACQUIRE, "agent");
            xb_add(&bar[XB_XGEN(b.x)], 1u);
            asm volatile("s_waitcnt vmcnt(0)" ::: "memory");
        } else {
            XB_SPIN(xb_ld(&bar[XB_XGEN(b.x)]) == gen, bar);
            __builtin_amdgcn_fence(__ATOMIC_ACQUIRE, "agent");
            asm volatile("s_waitcnt vmcnt(0)" ::: "memory");
        }
    }
    __syncthreads();
}


constexpr int NWAVES = 8;
constexpr int BATCH = 16, SEQ = 2048, D = 2048, DEPTH = 4, M = BATCH * SEQ;
constexpr int HG_PROJ = 8192, HG_HEADS = 16, HG_K = 128;
constexpr int GM_PROJ = 4096, GM_G = 16, GM_C = 128;
constexpr int FF = 5632, PLE = 256;
constexpr float EPS = 1e-6f;
constexpr int NPHASE = 1 + 9 * DEPTH;

#ifndef DIS_GMLP
#define DIS_GMLP 0
#endif
#ifndef DIS_HGRN
#define DIS_HGRN 0
#endif
#ifndef DIS_THIN
#define DIS_THIN 0
#endif
#ifndef NLOOP
#define NLOOP DEPTH
#endif
#ifndef DUP_MASK
#define DUP_MASK 0
#endif
#define DUP(n) (((DUP_MASK) >> (n)) & 1)
#ifndef HG_FILTER
#define HG_FILTER(t0, t) true
#endif
#ifndef HG_BOTH
#define HG_BOTH 0
#endif
#ifndef PG_ALIGN
#define PG_ALIGN true
#endif
#ifndef PG_SP2
#define PG_SP2 true
#endif
#ifndef THIN_NT
#define THIN_NT 1
#endif
#ifndef NT_G1H
#define NT_G1H 0
#endif
#ifndef NT_G1G
#define NT_G1G 0
#endif
#ifndef GMLP_NAIVE
#define GMLP_NAIVE 0
#endif
#ifndef HGRN_NAIVE
#define HGRN_NAIVE 0
#endif
#ifndef EN_MASK
#define EN_MASK 0xff
#endif
#define EN(n) (((EN_MASK) >> (n)) & 1)
#ifndef MK_ONE_LAUNCH
#define MK_ONE_LAUNCH 1
#endif

constexpr size_t MiB = 1u << 20;
constexpr size_t WS_CTL = 0, CTL_ZERO_BYTES = 65536;
constexpr size_t WS_W1 = 1 * MiB;
constexpr size_t WS_W2 = 33 * MiB;
constexpr size_t WS_WGU = 41 * MiB;
constexpr size_t WS_WD = 85 * MiB;
constexpr size_t WS_WPG = 107 * MiB;
constexpr size_t WS_WPP = 115 * MiB;
constexpr size_t WS_PB = 116 * MiB;
constexpr size_t WS_WST = 132 * MiB;
constexpr size_t WS_WSB = 133 * MiB;
constexpr size_t WS_A = 134 * MiB;
constexpr size_t WS_BIG = 262 * MiB;
constexpr size_t WS_MO = 774 * MiB;
constexpr size_t WS_END = 1030 * MiB;
constexpr int CW_BAR = 4096;

constexpr int RING_OFF = 0, RING_BYTES = 131072;
constexpr int LDSCTL_OFF = RING_BYTES, MISC_OFF = LDSCTL_OFF + 320, XTRA_OFF = LDSCTL_OFF + 1024;
constexpr int LDS_BYTES = 147456;

typedef unsigned v2u __attribute__((ext_vector_type(2)));
#if LBAR_SYNC
#define LBAR() __syncthreads()
#else
#define LBAR() do { asm volatile("s_waitcnt lgkmcnt(0)" ::: "memory"); __builtin_amdgcn_s_barrier(); asm volatile("" ::: "memory"); } while (0)
#endif
__device__ __forceinline__ float wave_sum(float v) {
#pragma unroll
    for (int o = 1; o < 64; o <<= 1) v += __shfl_xor(v, o);
    return v;
}
__device__ __forceinline__ float dot4(f32x4 a) { return (a.x * a.x + a.y * a.y) + (a.z * a.z + a.w * a.w); }
__device__ __forceinline__ float bf2f(unsigned short b) { return __builtin_bit_cast(float, ((unsigned)b) << 16); }
__device__ __forceinline__ float bfw(unsigned w, int hi) { return __builtin_bit_cast(float, hi ? (w & 0xffff0000u) : (w << 16)); }
__device__ __forceinline__ float sigm(float x) { return 1.0f / (1.0f + __expf(-x)); }

struct TItem { const float* W; bf16* WT; int K, N, mode, item; };
__device__ __forceinline__ void titem_load(const TItem& t, float (&v)[32], int lane) {
    const int nblk = t.N / 32, kb = t.item / nblk, nb = t.item % nblk, k0 = 64 * kb, n0 = 32 * nb;
    const float* src = t.W + (size_t)(k0 + (lane >> 5)) * t.N + n0 + (lane & 31);
#pragma unroll
    for (int i = 0; i < 32; ++i) v[i] = *(const GAS float*)(src + (size_t)(2 * i) * t.N);
}
__device__ __forceinline__ void titem_finish(const TItem& t, const float (&v)[32], LAS float* scr, int lane) {
    const int nblk = t.N / 32, kb = t.item / nblk, nb = t.item % nblk, k0 = 64 * kb, n0 = 32 * nb;
    const int d0 = t.mode == 0 ? n0 : ((n0 >> 7) * 256 + (n0 & 127) + (t.mode == 2 ? 128 : 0));
#pragma unroll
    for (int i = 0; i < 32; ++i) scr[(2 * i + (lane >> 5)) * 33 + (lane & 31)] = v[i];
    LDS_WAIT(); asm volatile("" ::: "memory");
    const int c = lane & 7;
#pragma unroll
    for (int j = 0; j < 4; ++j) { const int n = (lane >> 3) + 8 * j; const LAS float* s = scr + (8 * c) * 33 + n;
        v4u o; o.x = pk2(s[0 * 33], s[1 * 33]); o.y = pk2(s[2 * 33], s[3 * 33]); o.z = pk2(s[4 * 33], s[5 * 33]); o.w = pk2(s[6 * 33], s[7 * 33]);
        *(GAS v4u*)(t.WT + (size_t)(d0 + n) * t.K + k0 + 8 * c) = o; }
    LDS_WAIT(); asm volatile("" ::: "memory");
}

struct In { const float* p[22]; };

__device__ __forceinline__ void convert_layer(const In& in, unsigned char* ws, int L, LAS unsigned char* lds, int gw, int NGW, int wave, int lane) {
    asm volatile("" : "+v"(lane));
    LAS float* scr = (LAS float*)(lds + RING_OFF + wave * 16384);
    const int j = L >> 1;
    const bool odd = (L & 1) != 0;
    const float* w1 = odd ? in.p[6] + (size_t)j * D * GM_PROJ : in.p[2] + (size_t)j * D * HG_PROJ;
    const int n1 = odd ? GM_PROJ : HG_PROJ;
    const float* w2 = odd ? in.p[11] + (size_t)j * D * D : in.p[5] + (size_t)j * D * D;
    const float* wg = in.p[16] + (size_t)L * D * FF; const float* wu = in.p[17] + (size_t)L * D * FF; const float* wd = in.p[18] + (size_t)L * FF * D;
    const float* wpp = in.p[19] + (size_t)L * PLE * D; const float* wpg = in.p[20] + (size_t)L * D * D;
    const int I1 = (D / 64) * (n1 / 32), I2 = (D / 64) * (D / 32), IG = (D / 64) * (FF / 32), ID = (FF / 64) * (D / 32), IPP = (PLE / 64) * (D / 32);
    const int NITEMS = I1 + I2 + 2 * IG + ID + I2 + IPP;
#define CV_ITEM(t, it_) do { int r = (it_); \
        if (r < I1) { t = TItem{w1, (bf16*)(ws + WS_W1), D, n1, 0, r}; break; } r -= I1; \
        if (r < I2) { t = TItem{w2, (bf16*)(ws + WS_W2), D, D, 0, r}; break; } r -= I2; \
        if (r < IG) { t = TItem{wg, (bf16*)(ws + WS_WGU), D, FF, 1, r}; break; } r -= IG; \
        if (r < IG) { t = TItem{wu, (bf16*)(ws + WS_WGU), D, FF, 2, r}; break; } r -= IG; \
        if (r < ID) { t = TItem{wd, (bf16*)(ws + WS_WD), FF, D, 0, r}; break; } r -= ID; \
        if (r < I2) { t = TItem{wpg, (bf16*)(ws + WS_WPG), D, D, 0, r}; break; } r -= I2; \
        t = TItem{wpp, (bf16*)(ws + WS_WPP), PLE, D, 0, r}; } while (0)
    for (int it = gw; it < NITEMS; it += 2 * NGW) {
        TItem t0, t1; float v0[32], v1[32]; const bool has1 = (it + NGW < NITEMS);
        CV_ITEM(t0, it); titem_load(t0, v0, lane);
        if (has1) { CV_ITEM(t1, it + NGW); titem_load(t1, v1, lane); }
        titem_finish(t0, v0, scr, lane);
        if (has1) titem_finish(t1, v1, scr, lane);
    }
#undef CV_ITEM
    { const float* ps = in.p[1] + (size_t)L * M * PLE; bf16* pb = (bf16*)(ws + WS_PB);
      for (size_t i = (size_t)gw * 64 + lane; i < (size_t)M * PLE / 8; i += (size_t)NGW * 64) {
          const f32x4 a = *(const GAS f32x4*)(ps + i * 8), b = *(const GAS f32x4*)(ps + i * 8 + 4);
          v4u o; o.x = pk2(a.x, a.y); o.y = pk2(a.z, a.w); o.z = pk2(b.x, b.y); o.w = pk2(b.z, b.w);
          *(GAS v4u*)(pb + i * 8) = o; } }
    if (odd) {
        const float* wsrc = in.p[9] + (size_t)j * GM_G * GM_C * GM_C; float* wst = (float*)(ws + WS_WST);
        for (int i = gw * 64 + lane; i < GM_G * GM_C * GM_C; i += NGW * 64) { const int t = i & 127, s = (i >> 7) & 127, g = i >> 14;
            wst[i] = (s <= t) ? wsrc[(g * GM_C + t) * GM_C + s] : 0.f; }
        bf16* wsb = (bf16*)(ws + WS_WSB);
        for (int i = gw * 64 + lane; i < GM_G * GM_C * GM_C; i += NGW * 64) { const int s2 = i & 127, t2 = (i >> 7) & 127; wsb[i] = (bf16)((s2 <= t2) ? f2bf(wsrc[i]) : 0u); }
    }
}

__device__ __forceinline__ void norm_rows_to_bf16(const float* x, const float* g, bf16* A, int gw, int NGW, int lane) {
    for (int m = gw; m < M; m += NGW) {
        const GAS f32x4* xr = (const GAS f32x4*)(x + (size_t)m * D) + lane;
        f32x4 v[8]; float ss = 0.f;
#pragma unroll
        for (int j = 0; j < 8; ++j) { v[j] = xr[64 * j]; ss += dot4(v[j]); }
        const float rstd = __builtin_amdgcn_rsqf(wave_sum(ss) * (1.f / D) + EPS);
        GAS unsigned long long* o8 = (GAS unsigned long long*)(A + (size_t)m * D) + lane;
#pragma unroll
        for (int j = 0; j < 8; ++j) { const f32x4 gg = ((const GAS f32x4*)g)[lane + 64 * j]; const f32x4 a = v[j] * rstd * gg;
            o8[64 * j] = (unsigned long long)pk2(a.x, a.y) | ((unsigned long long)pk2(a.z, a.w) << 32); }
    }
}
struct ThinRow { f32x4 hv[8]; v4u hw[4]; v4u mw[4]; };
template <bool HIN_F32>
__device__ __forceinline__ void thin_load(ThinRow& r, const void* hin, const bf16* mo, int m, int lane) {
    const GAS v4u* mr = (const GAS v4u*)(mo + (size_t)m * D) + lane;
    if (HIN_F32) { const GAS f32x4* hr = (const GAS f32x4*)((const float*)hin + (size_t)m * D) + 2 * lane;
#pragma unroll
        for (int j = 0; j < 4; ++j) { r.mw[j] = THIN_NT ? __builtin_nontemporal_load(mr + 64 * j) : mr[64 * j]; r.hv[2 * j] = hr[128 * j]; r.hv[2 * j + 1] = hr[128 * j + 1]; } }
    else { const GAS v4u* hr = (const GAS v4u*)((const bf16*)hin + (size_t)m * D) + lane;
#pragma unroll
        for (int j = 0; j < 4; ++j) { r.mw[j] = THIN_NT ? __builtin_nontemporal_load(mr + 64 * j) : mr[64 * j]; r.hw[j] = (THIN_NT > 1) ? __builtin_nontemporal_load(hr + 64 * j) : hr[64 * j]; } }
}
template <bool HIN_F32, bool HOUT_F32, bool NORM_A>
__device__ __forceinline__ void thin_proc(ThinRow& r, const float* gpost, const float* gnext, void* hout, bf16* A, int m, int lane) {
    f32x4 mv[8]; float ss = 0.f;
#pragma unroll
    for (int j = 0; j < 4; ++j) { const v4u w = r.mw[j];
        mv[2 * j] = (f32x4){bfw(w.x, 0), bfw(w.x, 1), bfw(w.y, 0), bfw(w.y, 1)}; mv[2 * j + 1] = (f32x4){bfw(w.z, 0), bfw(w.z, 1), bfw(w.w, 0), bfw(w.w, 1)};
        ss += dot4(mv[2 * j]) + dot4(mv[2 * j + 1]);
        if (!HIN_F32) { const v4u hw = r.hw[j]; r.hv[2 * j] = (f32x4){bfw(hw.x, 0), bfw(hw.x, 1), bfw(hw.y, 0), bfw(hw.y, 1)}; r.hv[2 * j + 1] = (f32x4){bfw(hw.z, 0), bfw(hw.z, 1), bfw(hw.w, 0), bfw(hw.w, 1)}; } }
    const float rstd = __builtin_amdgcn_rsqf(wave_sum(ss) * (1.f / D) + EPS);
    float ss2 = 0.f;
#pragma unroll
    for (int j = 0; j < 4; ++j) {
#pragma unroll
        for (int h2 = 0; h2 < 2; ++h2) { const f32x4 gg = ((const GAS f32x4*)gpost)[2 * lane + 128 * j + h2]; r.hv[2 * j + h2] = r.hv[2 * j + h2] + mv[2 * j + h2] * rstd * gg; ss2 += dot4(r.hv[2 * j + h2]); }
        if (HOUT_F32) { GAS f32x4* ho = (GAS f32x4*)((float*)hout + (size_t)m * D) + 2 * lane; ho[128 * j] = r.hv[2 * j]; ho[128 * j + 1] = r.hv[2 * j + 1]; }
        else { GAS v4u* ho = (GAS v4u*)((bf16*)hout + (size_t)m * D) + lane; const f32x4 a0 = r.hv[2 * j], a1 = r.hv[2 * j + 1]; ho[64 * j] = (v4u){pk2(a0.x, a0.y), pk2(a0.z, a0.w), pk2(a1.x, a1.y), pk2(a1.z, a1.w)}; } }
    if (NORM_A) {
        const float r2 = __builtin_amdgcn_rsqf(wave_sum(ss2) * (1.f / D) + EPS);
        GAS v4u* o16 = (GAS v4u*)(A + (size_t)m * D) + lane;
#pragma unroll
        for (int j = 0; j < 4; ++j) { const f32x4 a0 = r.hv[2 * j] * r2 * ((const GAS f32x4*)gnext)[2 * lane + 128 * j], a1 = r.hv[2 * j + 1] * r2 * ((const GAS f32x4*)gnext)[2 * lane + 128 * j + 1];
            o16[64 * j] = (v4u){pk2(a0.x, a0.y), pk2(a0.z, a0.w), pk2(a1.x, a1.y), pk2(a1.z, a1.w)}; }
    }
}
template <bool HIN_F32, bool HOUT_F32, bool NORM_A>
__device__ __forceinline__ void thin_phase(const void* hin, const bf16* mo, const float* gpost, const float* gnext, void* hout, bf16* A, int gw, int NGW, int lane) {
    asm volatile("" : "+v"(lane));
    ThinRow r0, r1;
    if (gw < M) thin_load<HIN_F32>(r0, hin, mo, gw, lane);
    for (int m = gw; m < M; m += 2 * NGW) {
        const bool has1 = (m + NGW < M);
        if (has1) thin_load<HIN_F32>(r1, hin, mo, m + NGW, lane);
        thin_proc<HIN_F32, HOUT_F32, NORM_A>(r0, gpost, gnext, hout, A, m, lane);
        if (m + 2 * NGW < M) thin_load<HIN_F32>(r0, hin, mo, m + 2 * NGW, lane);
        if (has1) thin_proc<HIN_F32, HOUT_F32, NORM_A>(r1, gpost, gnext, hout, A, m + NGW, lane);
    }
}

__device__ __forceinline__ void hgrn_naive_phase(const bf16* proj, const float* lb_logits, int j, const float* out_norm, bf16* Y, LAS unsigned char* lds, int tid, int G) {
    asm volatile("" : "+v"(tid));
    LAS float* Q = (LAS float*)(lds);
    LAS float* F = Q + 2048; LAS float* KK = F + 2048; LAS float* V = KK + 2048; LAS float* Gt = V + 2048;
    LAS float* Po = Gt + 2048;
    const int tok = tid >> 5, c4 = (tid & 31) * 4, v = tid & 127, kg = tid >> 7;
    for (int u = blockIdx.x; u < BATCH * HG_HEADS; u += G) {
        const int b = u / HG_HEADS, hd = u % HG_HEADS;
        float lb[4], lbf[4], onw[4];
#pragma unroll
        for (int i = 0; i < 4; ++i) { const int ch = hd * HG_K + c4 + i; const float l0 = lb_logits[ch], l1 = lb_logits[2048 + ch];
            lb[i] = (j == 0) ? 0.f : 1.0f / (1.0f + __expf(l0 - l1)); lbf[i] = fmaxf(lb[i], 1e-30f); onw[i] = out_norm[c4 + i]; }
        float S[32];
#pragma unroll
        for (int i = 0; i < 32; ++i) S[i] = 0.f;
        for (int t0 = 0; t0 < SEQ; t0 += 16) {
            { const size_t row = (size_t)b * SEQ + t0 + tok; const bf16* pr = proj + row * HG_PROJ + hd * HG_K + c4;
              const v2u zq = *(const GAS v2u*)(pr), zf = *(const GAS v2u*)(pr + 2048), zi = *(const GAS v2u*)(pr + 4096), zg = *(const GAS v2u*)(pr + 6144);
              const unsigned qw[2] = {zq.x, zq.y}, fw[2] = {zf.x, zf.y}, iw[2] = {zi.x, zi.y}, gw2[2] = {zg.x, zg.y};
              f32x4 qv, fv, kv, vv, gv;
#pragma unroll
              for (int i = 0; i < 4; ++i) { const float a = bfw(qw[i >> 1], i & 1); qv[i] = a * sigm(a); const float z = bfw(fw[i >> 1], i & 1); fv[i] = lbf[i] + (1.0f - lb[i]) * sigm(z); kv[i] = (1.0f - lb[i]) * sigm(-z); vv[i] = bfw(iw[i >> 1], i & 1); gv[i] = bfw(gw2[i >> 1], i & 1); }
              const int o = tok * 128 + c4;
              *(LAS f32x4*)(Q + o) = qv; *(LAS f32x4*)(F + o) = fv; *(LAS f32x4*)(KK + o) = kv; *(LAS f32x4*)(V + o) = vv; *(LAS f32x4*)(Gt + o) = gv; }
            __syncthreads();
            for (int t = 0; t < 16; ++t) {
                const float vt = V[t * 128 + v]; float po = 0.f;
#pragma unroll
                for (int i4 = 0; i4 < 8; ++i4) { const int o = t * 128 + kg * 32 + i4 * 4; const f32x4 f4 = *(const LAS f32x4*)(F + o), k4 = *(const LAS f32x4*)(KK + o), q4 = *(const LAS f32x4*)(Q + o);
#pragma unroll
                    for (int e = 0; e < 4; ++e) { S[i4 * 4 + e] = f4[e] * S[i4 * 4 + e] + k4[e] * vt; po += S[i4 * 4 + e] * q4[e]; } }
                Po[(t * 4 + kg) * 128 + v] = po;
            }
            __syncthreads();
            { f32x4 o4 = *(const LAS f32x4*)(Po + (tok * 4 + 0) * 128 + c4);
#pragma unroll
              for (int g2 = 1; g2 < 4; ++g2) o4 = o4 + *(const LAS f32x4*)(Po + (tok * 4 + g2) * 128 + c4);
              float ss = dot4(o4);
#pragma unroll
              for (int o = 1; o < 32; o <<= 1) ss += __shfl_xor(ss, o);
              const float rstd = 1.0f / sqrtf(ss * (1.f / 128.f) + EPS);
              const f32x4 gv = *(const LAS f32x4*)(Gt + tok * 128 + c4);
              float y[4];
#pragma unroll
              for (int i = 0; i < 4; ++i) y[i] = o4[i] * rstd * onw[i] * (gv[i] * sigm(gv[i]));
              const size_t row = (size_t)b * SEQ + t0 + tok;
              *(GAS unsigned long long*)(Y + row * D + hd * HG_K + c4) = (unsigned long long)pk2(y[0], y[1]) | ((unsigned long long)pk2(y[2], y[3]) << 32); }
            __syncthreads();
        }
    }
}

__device__ __forceinline__ void gmlp_naive_phase(const bf16* z, const float* ln_g, const float* ln_b, const float* wst, const float* b_s, bf16* Y, LAS unsigned char* lds, int tid, int G) {
    asm volatile("" : "+v"(tid));
    LAS float* Vn = (LAS float*)(lds);
    LAS float* WT = Vn + 16384;
    LAS float* ST = (LAS float*)(lds + XTRA_OFF);
    const int lane = tid & 63, wave = tid >> 6;
    for (int u = blockIdx.x; u < BATCH * (SEQ / GM_C); u += G) {
        const size_t row0 = (size_t)u * GM_C;
        for (int r = wave * 16; r < wave * 16 + 16; ++r) {
            const bf16* vr = z + (row0 + r) * GM_PROJ + 2048 + lane * 8;
            float x[32]; float s = 0.f;
#pragma unroll
            for (int jj = 0; jj < 4; ++jj) { const v4u w = *(const GAS v4u*)(vr + 512 * jj); const unsigned ww[4] = {w.x, w.y, w.z, w.w};
#pragma unroll
                for (int e = 0; e < 4; ++e) { x[jj * 8 + 2 * e] = __builtin_bit_cast(float, ww[e] << 16); x[jj * 8 + 2 * e + 1] = __builtin_bit_cast(float, ww[e] & 0xffff0000u); s += x[jj * 8 + 2 * e] + x[jj * 8 + 2 * e + 1]; } }
            const float mean = wave_sum(s) * (1.f / 2048.f); float q = 0.f;
#pragma unroll
            for (int e = 0; e < 32; ++e) { const float d = x[e] - mean; q += d * d; }
            const float rstd = 1.0f / sqrtf(wave_sum(q) * (1.f / 2048.f) + EPS);
            if (lane == 0) { ST[2 * r] = mean; ST[2 * r + 1] = rstd; }
        }
        __syncthreads();
        for (int g = 0; g < GM_G; ++g) {
#pragma unroll
            for (int i = 0; i < 4; ++i) { const int s = (tid >> 4) + 32 * i, c8 = (tid & 15) * 8;
                const v4u w = *(const GAS v4u*)(z + (row0 + s) * GM_PROJ + 2048 + g * GM_C + c8); const unsigned ww[4] = {w.x, w.y, w.z, w.w};
                const float mean = ST[2 * s], rstd = ST[2 * s + 1];
                const f32x4 g0 = *(const GAS f32x4*)(ln_g + g * GM_C + c8), g1 = *(const GAS f32x4*)(ln_g + g * GM_C + c8 + 4), b0 = *(const GAS f32x4*)(ln_b + g * GM_C + c8), b1 = *(const GAS f32x4*)(ln_b + g * GM_C + c8 + 4);
                f32x4 o0, o1;
                o0.x = (__builtin_bit_cast(float, ww[0] << 16) - mean) * rstd * g0.x + b0.x; o0.y = (__builtin_bit_cast(float, ww[0] & 0xffff0000u) - mean) * rstd * g0.y + b0.y;
                o0.z = (__builtin_bit_cast(float, ww[1] << 16) - mean) * rstd * g0.z + b0.z; o0.w = (__builtin_bit_cast(float, ww[1] & 0xffff0000u) - mean) * rstd * g0.w + b0.w;
                o1.x = (__builtin_bit_cast(float, ww[2] << 16) - mean) * rstd * g1.x + b1.x; o1.y = (__builtin_bit_cast(float, ww[2] & 0xffff0000u) - mean) * rstd * g1.y + b1.y;
                o1.z = (__builtin_bit_cast(float, ww[3] << 16) - mean) * rstd * g1.z + b1.z; o1.w = (__builtin_bit_cast(float, ww[3] & 0xffff0000u) - mean) * rstd * g1.w + b1.w;
                *(LAS f32x4*)(Vn + s * 128 + c8) = o0; *(LAS f32x4*)(Vn + s * 128 + c8 + 4) = o1; }
#pragma unroll
            for (int i = 0; i < 8; ++i) { const int e4 = tid + 512 * i; *(LAS f32x4*)(WT + e4 * 4) = *(const GAS f32x4*)(wst + (size_t)g * 16384 + e4 * 4); }
            __syncthreads();
            { int tid2 = tid; asm volatile("" : "+v"(tid2)); const int c = tid2 & 127, tq = tid2 >> 7; float acc[32];
#pragma unroll
              for (int i = 0; i < 32; ++i) acc[i] = 0.f;
              const int smax = tq * 32 + 32;
              for (int s = 0; s < smax; ++s) { const float vn = Vn[s * 128 + c];
#pragma unroll
                  for (int i4 = 0; i4 < 8; ++i4) { const f32x4 w4 = *(const LAS f32x4*)(WT + s * 128 + tq * 32 + i4 * 4);
#pragma unroll
                      for (int e = 0; e < 4; ++e) acc[i4 * 4 + e] += w4[e] * vn; } }
#pragma unroll
              for (int i = 0; i < 32; ++i) { const int t = tq * 32 + i; const size_t row = row0 + t;
                  const float uu = bf2f(z[row * GM_PROJ + g * GM_C + c]); const float yv = uu * (acc[i] + b_s[g * GM_C + t]);
                  Y[row * D + g * GM_C + c] = (bf16)f2bf(yv); } }
            __syncthreads();
        }
    }
}


__device__ __forceinline__ void gmlp_mfma_phase(const bf16* z, const float* ln_g, const float* ln_b, const bf16* wsb, const float* b_s, bf16* Y, LAS unsigned char* lds, int tid, int G) {
    asm volatile("" : "+v"(tid));
    constexpr int VSTR = 272;
    LAS float* ST = (LAS float*)(lds + XTRA_OFF);
    const int lane = tid & 63, wave = __builtin_amdgcn_readfirstlane(tid >> 6);
    const int l15 = lane & 15, lg = lane >> 4;
    for (int u = blockIdx.x; u < BATCH * (SEQ / GM_C); u += G) {
        const size_t row0 = (size_t)u * GM_C;
#pragma unroll 1
        for (int rb = 0; rb < 4; ++rb) {
            v4u raw4[4][4];
#pragma unroll
            for (int q = 0; q < 4; ++q) { const bf16* vr = z + (row0 + wave * 16 + rb * 4 + q) * GM_PROJ + 2048 + lane * 8;
#pragma unroll
                for (int jj = 0; jj < 4; ++jj) raw4[q][jj] = *(const GAS v4u*)(vr + 512 * jj); }
#pragma unroll
            for (int q = 0; q < 4; ++q) { float x[32]; float sm = 0.f;
#pragma unroll
                for (int jj = 0; jj < 4; ++jj) { const v4u w = raw4[q][jj]; const unsigned ww[4] = {w.x, w.y, w.z, w.w};
#pragma unroll
                    for (int e = 0; e < 4; ++e) { x[jj * 8 + 2 * e] = bfw(ww[e], 0); x[jj * 8 + 2 * e + 1] = bfw(ww[e], 1); sm += x[jj * 8 + 2 * e] + x[jj * 8 + 2 * e + 1]; } }
                const float mean = wave_sum(sm) * (1.f / 2048.f); float qq = 0.f;
#pragma unroll
                for (int e = 0; e < 32; ++e) { const float d = x[e] - mean; qq += d * d; }
                const float rstd = __builtin_amdgcn_rsqf(wave_sum(qq) * (1.f / 2048.f) + EPS);
                if (lane == 0) { const int r = wave * 16 + rb * 4 + q; ST[2 * r] = mean; ST[2 * r + 1] = rstd; } }
        }
        const bf16* src0 = z + (row0 + 16 * wave) * GM_PROJ + 2048 + 2 * lane;
        unsigned raw[16];
#pragma unroll
        for (int i = 0; i < 16; ++i) raw[i] = *(const GAS unsigned*)(src0 + (size_t)i * GM_PROJ);
        LBAR();
        for (int g = 0; g < GM_G; ++g) {
            LAS unsigned char* VT = lds + (g & 1) * (128 * VSTR);
            {
                const int cp = lane;
                const float g0 = ln_g[g * GM_C + 2 * cp], g1 = ln_g[g * GM_C + 2 * cp + 1], b0 = ln_b[g * GM_C + 2 * cp], b1 = ln_b[g * GM_C + 2 * cp + 1];
                unsigned lo[8], hi[8];
#pragma unroll
                for (int i = 0; i < 8; ++i) { const f32x4 st = *(const LAS f32x4*)(ST + 2 * (16 * wave + 2 * i));
                    const float x00 = (bfw(raw[2 * i], 0) - st.x) * st.y * g0 + b0, x01 = (bfw(raw[2 * i], 1) - st.x) * st.y * g1 + b1;
                    const float x10 = (bfw(raw[2 * i + 1], 0) - st.z) * st.w * g0 + b0, x11 = (bfw(raw[2 * i + 1], 1) - st.z) * st.w * g1 + b1;
                    lo[i] = pk2(x00, x10); hi[i] = pk2(x01, x11); }
                LAS unsigned char* d0 = VT + (2 * cp) * VSTR + 32 * wave;
                *(LAS v4u*)(d0) = (v4u){lo[0], lo[1], lo[2], lo[3]}; *(LAS v4u*)(d0 + 16) = (v4u){lo[4], lo[5], lo[6], lo[7]};
                *(LAS v4u*)(d0 + VSTR) = (v4u){hi[0], hi[1], hi[2], hi[3]}; *(LAS v4u*)(d0 + VSTR + 16) = (v4u){hi[4], hi[5], hi[6], hi[7]};
            }
            if (g + 1 < GM_G) {
#pragma unroll
                for (int i = 0; i < 16; ++i) raw[i] = *(const GAS unsigned*)(src0 + (g + 1) * GM_C + (size_t)i * GM_PROJ);
            }
            const int t = 16 * wave + l15; const size_t row = row0 + t;
            const bf16* up = z + row * GM_PROJ + g * GM_C + 4 * lg;
            v2u uu[8];
#pragma unroll
            for (int ct = 0; ct < 8; ++ct) uu[ct] = *(const GAS v2u*)(up + 16 * ct);
            const float bs = b_s[g * GM_C + t];
            const int nk = (wave >> 1) + 1;
            const bf16* wrow = wsb + ((size_t)g * GM_C + 16 * wave + l15) * GM_C + 8 * lg;
            bf16x8 wf[4];
#pragma unroll
            for (int ks = 0; ks < 4; ++ks) if (ks < nk) wf[ks] = *(const GAS bf16x8*)(wrow + 32 * ks);
            LBAR();
            f32x4 acc[8];
#pragma unroll
            for (int ct = 0; ct < 8; ++ct) acc[ct] = (f32x4){0.f, 0.f, 0.f, 0.f};
#pragma unroll
            for (int ks = 0; ks < 4; ++ks) if (ks < nk) {
#pragma unroll
                for (int ct = 0; ct < 8; ++ct) { const bf16x8 vf = *(const LAS bf16x8*)(VT + (16 * ct + l15) * VSTR + 64 * ks + 16 * lg);
                    acc[ct] = __builtin_amdgcn_mfma_f32_16x16x32_bf16(vf, wf[ks], acc[ct], 0, 0, 0); }
            }
            { bf16* yp = Y + row * D + g * GM_C + 4 * lg;
#pragma unroll
              for (int ct = 0; ct < 8; ++ct) { const unsigned ux = uu[ct].x, uy = uu[ct].y;
                  v2u o; o.x = pk2(bfw(ux, 0) * (acc[ct][0] + bs), bfw(ux, 1) * (acc[ct][1] + bs)); o.y = pk2(bfw(uy, 0) * (acc[ct][2] + bs), bfw(uy, 1) * (acc[ct][3] + bs));
                  *(GAS v2u*)(yp + 16 * ct) = o; } }
        }
        LBAR();
    }
}

typedef __bf16 bf16x2_t __attribute__((ext_vector_type(2)));
__device__ __forceinline__ unsigned cvtpk(float lo, float hi) { const pg8::f32x2 v = {lo, hi}; return __builtin_bit_cast(unsigned, __builtin_convertvector(v, bf16x2_t)); }
__device__ __forceinline__ void hgrn_mfma_phase(const bf16* proj, const float* lb_logits, int j, const float* out_norm, bf16* Y, LAS unsigned char* lds, int tid, int G) {
    asm volatile("" : "+v"(tid));
    constexpr int QS = 272, TS = 80, OS = 528;
    LAS unsigned char* const QT = lds;
    LAS unsigned char* const KT = lds + 8704;
    LAS unsigned char* const KHT = lds + 17408;
    LAS unsigned char* const VT = lds + 27648;
    LAS unsigned char* const AM = lds + 37888;
    LAS unsigned char* const OB = lds + 40448;
    LAS unsigned char* const GT = lds + 57344;
    LAS float* const TOT = (LAS float*)(lds + 65536);
    LAS float* const DL = (LAS float*)(lds + 69632);
    const int lane = tid & 63, wave = __builtin_amdgcn_readfirstlane(tid >> 6), l15 = lane & 15, lg = lane >> 4;
    const int t_o = tid >> 4, v8 = (tid & 15) * 8;
    for (int u = blockIdx.x; u < BATCH * HG_HEADS; u += G) {
        const int b = u / HG_HEADS, hd = u % HG_HEADS;
        float lbf[2], oml[2];
#pragma unroll
        for (int e = 0; e < 2; ++e) { const int ch = hd * HG_K + 2 * lane + e; const float l0 = lb_logits[ch], l1 = lb_logits[2048 + ch];
            const float lb = (j == 0) ? 0.f : 1.0f / (1.0f + __expf(l0 - l1)); lbf[e] = fmaxf(lb, 1e-30f); oml[e] = 1.0f - lb; }
        float onw[8];
#pragma unroll
        for (int i = 0; i < 8; ++i) onw[i] = out_norm[v8 + i];
        f32x4 S[8];
#pragma unroll
        for (int kt = 0; kt < 8; ++kt) S[kt] = (f32x4){0.f, 0.f, 0.f, 0.f};
        const bf16* base = proj + ((size_t)b * SEQ + 4 * wave) * HG_PROJ + hd * HG_K + 2 * lane;
        unsigned rq[4], rf[4], ri[4], rg[4];
#pragma unroll
        for (int i = 0; i < 4; ++i) { const bf16* p = base + (size_t)i * HG_PROJ; rq[i] = *(const GAS unsigned*)p; rf[i] = *(const GAS unsigned*)(p + 2048); ri[i] = *(const GAS unsigned*)(p + 4096); rg[i] = *(const GAS unsigned*)(p + 6144); }
        for (int t0 = 0; t0 < SEQ; t0 += 32) {
            float q[4][2], kk[4][2], cs[4][2];
#pragma unroll
            for (int i = 0; i < 4; ++i)
#pragma unroll
                for (int e = 0; e < 2; ++e) { const float zq = bfw(rq[i], e); q[i][e] = zq * __builtin_amdgcn_rcpf(1.0f + __builtin_amdgcn_exp2f(-1.4426950408889634f * zq));
                    const float zf = fmaxf(bfw(rf[i], e), -80.f); const float en = __builtin_amdgcn_exp2f(-1.4426950408889634f * zf), sg = __builtin_amdgcn_rcpf(1.0f + en);
                    const float lf = __builtin_amdgcn_logf(lbf[e] + oml[e] * sg); kk[i][e] = oml[e] * en * sg; cs[i][e] = (i == 0) ? lf : cs[i - 1][e] + lf; }
            *(LAS pg8::f32x2*)(TOT + wave * 128 + 2 * lane) = (pg8::f32x2){cs[3][0], cs[3][1]};
#pragma unroll
            for (int i = 0; i < 4; ++i) *(LAS unsigned*)(GT + (4 * wave + i) * 256 + 4 * lane) = rg[i];
            *(LAS v2u*)(VT + (2 * lane) * TS + 8 * wave) = (v2u){(ri[0] & 0xffffu) | (ri[1] << 16), (ri[2] & 0xffffu) | (ri[3] << 16)};
            *(LAS v2u*)(VT + (2 * lane + 1) * TS + 8 * wave) = (v2u){(ri[0] >> 16) | (ri[1] & 0xffff0000u), (ri[2] >> 16) | (ri[3] & 0xffff0000u)};
            if (t0 + 32 < SEQ) {
#pragma unroll
                for (int i = 0; i < 4; ++i) { const bf16* p = base + (size_t)(t0 + 32 + i) * HG_PROJ; rq[i] = *(const GAS unsigned*)p; rf[i] = *(const GAS unsigned*)(p + 2048); ri[i] = *(const GAS unsigned*)(p + 4096); rg[i] = *(const GAS unsigned*)(p + 6144); }
            }
            LBAR();
            { float pre[2] = {0.f, 0.f}, tot[2] = {0.f, 0.f};
#pragma unroll
              for (int w2 = 0; w2 < 8; ++w2) { const pg8::f32x2 tv = *(const LAS pg8::f32x2*)(TOT + w2 * 128 + 2 * lane); const float a0 = tv.x, a1 = tv.y;
                  tot[0] += a0; tot[1] += a1; if (w2 < wave) { pre[0] += a0; pre[1] += a1; } }
              float kh[4][2];
#pragma unroll
              for (int i = 0; i < 4; ++i) { float qt[2], kt2[2];
#pragma unroll
                  for (int e = 0; e < 2; ++e) { const float bb = pre[e] + cs[i][e];
                      qt[e] = q[i][e] * __builtin_amdgcn_exp2f(bb); kt2[e] = kk[i][e] * __builtin_amdgcn_exp2f(fminf(-bb, 115.f)); kh[i][e] = kk[i][e] * __builtin_amdgcn_exp2f(tot[e] - bb); }
                  *(LAS unsigned*)(QT + (4 * wave + i) * QS + 4 * lane) = cvtpk(qt[0], qt[1]);
                  *(LAS unsigned*)(KT + (4 * wave + i) * QS + 4 * lane) = cvtpk(kt2[0], kt2[1]); }
              *(LAS v2u*)(KHT + (2 * lane) * TS + 8 * wave) = (v2u){cvtpk(kh[0][0], kh[1][0]), cvtpk(kh[2][0], kh[3][0])};
              *(LAS v2u*)(KHT + (2 * lane + 1) * TS + 8 * wave) = (v2u){cvtpk(kh[0][1], kh[1][1]), cvtpk(kh[2][1], kh[3][1])};
              if (wave == 0) *(LAS pg8::f32x2*)(DL + 2 * lane) = (pg8::f32x2){__builtin_amdgcn_exp2f(tot[0]), __builtin_amdgcn_exp2f(tot[1])}; }
            LBAR();
            if (wave < 3) { const int tt = wave ? 1 : 0, st = (wave == 2) ? 1 : 0; f32x4 am = (f32x4){0.f, 0.f, 0.f, 0.f};
#pragma unroll
                for (int k4 = 0; k4 < 4; ++k4) { const bf16x8 a = *(const LAS bf16x8*)(QT + (16 * tt + l15) * QS + 64 * k4 + 16 * lg); const bf16x8 bq = *(const LAS bf16x8*)(KT + (16 * st + l15) * QS + 64 * k4 + 16 * lg);
                    am = __builtin_amdgcn_mfma_f32_16x16x32_bf16(a, bq, am, 0, 0, 0); }
#pragma unroll
                for (int r = 0; r < 4; ++r) { const int tl = 4 * lg + r; const float val = (tt != st || l15 <= tl) ? am[r] : 0.f;
                    *(LAS unsigned short*)(AM + (16 * tt + tl) * TS + (16 * st + l15) * 2) = (unsigned short)f2bf(val); } }
            else if (wave == 3) {
#pragma unroll
                for (int r = 0; r < 4; ++r) *(LAS unsigned short*)(AM + (4 * lg + r) * TS + (16 + l15) * 2) = (unsigned short)0; }
            f32x4 o[2] = {(f32x4){0.f, 0.f, 0.f, 0.f}, (f32x4){0.f, 0.f, 0.f, 0.f}};
#pragma unroll
            for (int k2 = 0; k2 < 4; ++k2) {
                const v4u sb = (v4u){cvtpk(S[2 * k2][0], S[2 * k2][1]), cvtpk(S[2 * k2][2], S[2 * k2][3]), cvtpk(S[2 * k2 + 1][0], S[2 * k2 + 1][1]), cvtpk(S[2 * k2 + 1][2], S[2 * k2 + 1][3])};
                const bf16x8 sfrag = __builtin_bit_cast(bf16x8, sb);
#pragma unroll
                for (int tt = 0; tt < 2; ++tt) { const LAS unsigned char* qp = QT + (16 * tt + l15) * QS + (32 * k2 + 4 * lg) * 2;
                    const v2u lo = *(const LAS v2u*)qp, hi = *(const LAS v2u*)(qp + 32);
                    const bf16x8 a = __builtin_bit_cast(bf16x8, (v4u){lo.x, lo.y, hi.x, hi.y});
                    o[tt] = __builtin_amdgcn_mfma_f32_16x16x32_bf16(a, sfrag, o[tt], 0, 0, 0); }
            }
            LBAR();
            { const bf16x8 vfrag = *(const LAS bf16x8*)(VT + (16 * wave + l15) * TS + 16 * lg);
#pragma unroll
              for (int tt = 0; tt < 2; ++tt) { const bf16x8 a = *(const LAS bf16x8*)(AM + (16 * tt + l15) * TS + 16 * lg); o[tt] = __builtin_amdgcn_mfma_f32_16x16x32_bf16(a, vfrag, o[tt], 0, 0, 0);
#pragma unroll
                  for (int r = 0; r < 4; ++r) *(LAS float*)(OB + (16 * tt + 4 * lg + r) * OS + (16 * wave + l15) * 4) = o[tt][r]; }
#pragma unroll
              for (int kt = 0; kt < 8; ++kt) { const f32x4 d4 = *(const LAS f32x4*)(DL + 16 * kt + 4 * lg); const bf16x8 a = *(const LAS bf16x8*)(KHT + (16 * kt + l15) * TS + 16 * lg);
                  S[kt] = __builtin_amdgcn_mfma_f32_16x16x32_bf16(a, vfrag, S[kt] * d4, 0, 0, 0); } }
            LBAR();
            { const f32x4 o0 = *(const LAS f32x4*)(OB + t_o * OS + v8 * 4), o1 = *(const LAS f32x4*)(OB + t_o * OS + v8 * 4 + 16);
              float ss = dot4(o0) + dot4(o1);
#pragma unroll
              for (int m = 1; m < 16; m <<= 1) ss += __shfl_xor(ss, m);
              const float rstd = __builtin_amdgcn_rsqf(ss * (1.f / 128.f) + EPS);
              const v4u gr = *(const LAS v4u*)(GT + t_o * 256 + v8 * 2); const unsigned gw4[4] = {gr.x, gr.y, gr.z, gr.w};
              float y[8];
#pragma unroll
              for (int i = 0; i < 8; ++i) { const float gv = bfw(gw4[i >> 1], i & 1); const float ov = (i < 4) ? o0[i & 3] : o1[i & 3]; y[i] = ov * rstd * onw[i] * (gv * __builtin_amdgcn_rcpf(1.0f + __builtin_amdgcn_exp2f(-1.4426950408889634f * gv))); }
              if (HG_FILTER(t0, t_o)) *(GAS v4u*)(Y + ((size_t)b * SEQ + t0 + t_o) * D + hd * HG_K + v8) = (v4u){pk2(y[0], y[1]), pk2(y[2], y[3]), pk2(y[4], y[5]), pk2(y[6], y[7])}; }
            LBAR();
        }
    }
}

struct Args { In in; float* out; unsigned char* ws; int ph_lo, ph_hi; };
__global__ void __launch_bounds__(NWAVES * 64, 2) fwd(Args args) {
    extern __shared__ __attribute__((aligned(16))) unsigned char lds_raw[];
    LAS unsigned char* lds = (LAS unsigned char*)lds_raw;
    volatile LAS unsigned* MISC = (volatile LAS unsigned*)(lds + MISC_OFF);
    const int tid = threadIdx.x, lane = tid & 63, wave = __builtin_amdgcn_readfirstlane(tid >> 6);
    const int G = gridDim.x; const int bx = blockIdx.x; const int vcu = (G % 8 == 0) ? (bx % 8) * (G / 8) + bx / 8 : bx;
    const int gw = vcu * NWAVES + wave, NGW = G * NWAVES;
    unsigned char* ws = args.ws; gu32* ctl = (gu32*)(ws + WS_CTL);
    for (int u = tid; u < (LDS_BYTES - LDSCTL_OFF) / 4; u += NWAVES * 64) ((LAS unsigned*)(lds + LDSCTL_OFF))[u] = 0u;
    __syncthreads();
    XcdBarrier bar; bar.bar = (unsigned*)(ctl + CW_BAR); bar.x = 0; bar.st = nullptr;
    if (MK_ONE_LAUNCH) bar = xcd_barrier_post((unsigned*)(ctl + CW_BAR), MISC + 8);
    const int lo = args.ph_lo, hi = args.ph_hi;
#define IN(k) (lo <= (k) && (k) < hi)
#define SEAM(k) do { if (IN(k) && IN((k) + 1)) { xcd_barrier(bar); if (DUP(12)) xcd_barrier(bar); } } while (0)
    const In& in = args.in;
    bf16* const A = (bf16*)(ws + WS_A); bf16* const BIG = (bf16*)(ws + WS_BIG); bf16* const MO = (bf16*)(ws + WS_MO); bf16* const H16 = (bf16*)(ws + WS_MO + 128 * MiB);
    float* const out = args.out;

    if (!DIS_THIN && IN(0)) { convert_layer(in, ws, 0, lds, gw, NGW, wave, lane); norm_rows_to_bf16(in.p[0], in.p[12], A, gw, NGW, lane); }
    SEAM(0);

    for (int L = 0; L < NLOOP; ++L) {
        const int pb = 1 + 9 * L, j = L >> 1;
        if (L & 1) {
            if (EN(0) && IN(pb)) { pg8::Gemm g{A, (const bf16*)(ws + WS_W1), M, GM_PROJ, D}; pg8::StaticOrder S; S.init(M, GM_PROJ, G, bx);
                pg8::EpiBf16<1> E{BIG, GM_PROJ, NT_G1G}; pg8::gemm_phase<pg8::EpiBf16<1>, pg8::StaticOrder, PG_ALIGN, PG_SP2>(lds + RING_OFF, g, S, E); if (DUP(0)) { __syncthreads(); pg8::gemm_phase<pg8::EpiBf16<1>, pg8::StaticOrder, PG_ALIGN, PG_SP2>(lds + RING_OFF, g, S, E); } }
            SEAM(pb);
            if (!DIS_GMLP && IN(pb + 1)) {
#if GMLP_NAIVE
                gmlp_naive_phase(BIG, in.p[7] + j * 2048, in.p[8] + j * 2048, (const float*)(ws + WS_WST), in.p[10] + j * GM_G * GM_C, A, lds, tid, G);
                if (DUP(6)) gmlp_naive_phase(BIG, in.p[7] + j * 2048, in.p[8] + j * 2048, (const float*)(ws + WS_WST), in.p[10] + j * GM_G * GM_C, A, lds, tid, G);
#else
                gmlp_mfma_phase(BIG, in.p[7] + j * 2048, in.p[8] + j * 2048, (const bf16*)(ws + WS_WSB), in.p[10] + j * GM_G * GM_C, A, lds, tid, G);
                if (DUP(6)) gmlp_mfma_phase(BIG, in.p[7] + j * 2048, in.p[8] + j * 2048, (const bf16*)(ws + WS_WSB), in.p[10] + j * GM_G * GM_C, A, lds, tid, G);
#endif
            }
            SEAM(pb + 1);
        } else {
            if (EN(1) && IN(pb)) { pg8::Gemm g{A, (const bf16*)(ws + WS_W1), M, HG_PROJ, D}; pg8::StaticOrder S; S.init(M, HG_PROJ, G, bx);
                pg8::EpiBf16<0> E{BIG, HG_PROJ, NT_G1H}; pg8::gemm_phase<pg8::EpiBf16<0>, pg8::StaticOrder, PG_ALIGN, PG_SP2>(lds + RING_OFF, g, S, E); if (DUP(1)) { __syncthreads(); pg8::gemm_phase<pg8::EpiBf16<0>, pg8::StaticOrder, PG_ALIGN, PG_SP2>(lds + RING_OFF, g, S, E); } }
            SEAM(pb);
            if (!DIS_HGRN && IN(pb + 1)) {
#if HGRN_NAIVE
                hgrn_naive_phase(BIG, in.p[3], j, in.p[4] + j * HG_K, A, lds, tid, G);
                if (DUP(7)) hgrn_naive_phase(BIG, in.p[3], j, in.p[4] + j * HG_K, A, lds, tid, G);
#else
                if (HG_BOTH) { hgrn_naive_phase(BIG, in.p[3], j, in.p[4] + j * HG_K, A, lds, tid, G); __syncthreads(); }
                hgrn_mfma_phase(BIG, in.p[3], j, in.p[4] + j * HG_K, A, lds, tid, G);
                if (DUP(7)) hgrn_mfma_phase(BIG, in.p[3], j, in.p[4] + j * HG_K, A, lds, tid, G);
#endif
            }
            SEAM(pb + 1);
        }
        if (EN(2) && IN(pb + 2)) { pg8::Gemm g{A, (const bf16*)(ws + WS_W2), M, D, D}; pg8::StaticOrder S; S.init(M, D, G, bx);
            pg8::EpiBf16<0> E{MO, D, 0}; pg8::gemm_phase<pg8::EpiBf16<0>, pg8::StaticOrder, PG_ALIGN, PG_SP2>(lds + RING_OFF, g, S, E); if (DUP(2)) { __syncthreads(); pg8::gemm_phase<pg8::EpiBf16<0>, pg8::StaticOrder, PG_ALIGN, PG_SP2>(lds + RING_OFF, g, S, E); } }
        SEAM(pb + 2);
        if (!DIS_THIN && IN(pb + 3)) { if (L == 0) thin_phase<true, false, true>(in.p[0], MO, in.p[13] + L * D, in.p[14] + L * D, H16, A, gw, NGW, lane);
            else thin_phase<false, false, true>(H16, MO, in.p[13] + L * D, in.p[14] + L * D, H16, A, gw, NGW, lane); }
        SEAM(pb + 3);
        if (EN(3) && IN(pb + 4)) { pg8::Gemm g{A, (const bf16*)(ws + WS_WGU), M, 2 * FF, D}; pg8::StaticOrder S; S.init(M, 2 * FF, G, bx);
            pg8::EpiSwiGLU E{BIG, FF}; pg8::gemm_phase<pg8::EpiSwiGLU, pg8::StaticOrder, PG_ALIGN, PG_SP2>(lds + RING_OFF, g, S, E); if (DUP(10)) { __syncthreads(); pg8::gemm_phase<pg8::EpiSwiGLU, pg8::StaticOrder, PG_ALIGN, PG_SP2, true>(lds + RING_OFF, g, S, E); } if (DUP(3)) { __syncthreads(); pg8::gemm_phase<pg8::EpiSwiGLU, pg8::StaticOrder, PG_ALIGN, PG_SP2>(lds + RING_OFF, g, S, E); } }
        SEAM(pb + 4);
        if (EN(4) && IN(pb + 5)) { pg8::Gemm g{BIG, (const bf16*)(ws + WS_WD), M, D, FF}; pg8::StaticOrder S; S.init(M, D, G, bx);
            pg8::EpiBf16<0> E{MO, D, 0}; pg8::gemm_phase<pg8::EpiBf16<0>, pg8::StaticOrder, PG_ALIGN, PG_SP2>(lds + RING_OFF, g, S, E); if (DUP(4)) { __syncthreads(); pg8::gemm_phase<pg8::EpiBf16<0>, pg8::StaticOrder, PG_ALIGN, PG_SP2>(lds + RING_OFF, g, S, E); } }
        SEAM(pb + 5);
        if (!DIS_THIN && IN(pb + 6)) thin_phase<false, false, false>(H16, MO, in.p[15] + L * D, nullptr, H16, nullptr, gw, NGW, lane);
        SEAM(pb + 6);
        if (IN(pb + 7)) {
            if (EN(5)) { pg8::Gemm g{(const bf16*)(ws + WS_PB), (const bf16*)(ws + WS_WPP), M, D, PLE}; pg8::StaticOrder S; S.init(M, D, G, bx);
              pg8::EpiBf16<0> E{MO, D, 0}; pg8::gemm_phase<pg8::EpiBf16<0>, pg8::StaticOrder, PG_ALIGN, PG_SP2>(lds + RING_OFF, g, S, E); }
            __syncthreads();
            if (EN(6)) { pg8::Gemm g{H16, (const bf16*)(ws + WS_WPG), M, D, D}; pg8::StaticOrder S; S.init(M, D, G, bx);
              pg8::EpiGateMulBf16 E{MO, D}; pg8::gemm_phase<pg8::EpiGateMulBf16, pg8::StaticOrder, PG_ALIGN, PG_SP2>(lds + RING_OFF, g, S, E); }
            if (DUP(5)) { __syncthreads();
            if (EN(5)) { pg8::Gemm g{(const bf16*)(ws + WS_PB), (const bf16*)(ws + WS_WPP), M, D, PLE}; pg8::StaticOrder S; S.init(M, D, G, bx);
              pg8::EpiBf16<0> E{MO, D, 0}; pg8::gemm_phase<pg8::EpiBf16<0>, pg8::StaticOrder, PG_ALIGN, PG_SP2>(lds + RING_OFF, g, S, E); }
            __syncthreads();
            if (EN(6)) { pg8::Gemm g{H16, (const bf16*)(ws + WS_WPG), M, D, D}; pg8::StaticOrder S; S.init(M, D, G, bx);
              pg8::EpiGateMulBf16 E{MO, D}; pg8::gemm_phase<pg8::EpiGateMulBf16, pg8::StaticOrder, PG_ALIGN, PG_SP2>(lds + RING_OFF, g, S, E); }
            }
        }
        SEAM(pb + 7);
        if (!DIS_THIN && IN(pb + 8)) {
            if (L + 1 < DEPTH) { thin_phase<false, false, true>(H16, MO, in.p[21] + L * D, in.p[12] + (L + 1) * D, H16, A, gw, NGW, lane); __syncthreads(); convert_layer(in, ws, L + 1, lds, gw, NGW, wave, lane); if (DUP(9)) { __syncthreads(); convert_layer(in, ws, L + 1, lds, gw, NGW, wave, lane); } }
            else thin_phase<false, true, false>(H16, MO, in.p[21] + L * D, nullptr, out, nullptr, gw, NGW, lane);
        }
        SEAM(pb + 8);
    }
#undef IN
#undef SEAM
}

extern "C" void kernel_launch(void* const* d_in, const int* in_sizes, int n_in, void* d_out, int out_size, void* d_ws, size_t ws_size, hipStream_t stream) {
    static int grid = 0;
    if (grid == 0) {
        if (n_in != 22 || out_size != M * D || ws_size < WS_END) { fprintf(stderr, "kernel_launch: unexpected shapes: n_in %d out %d ws %zu (need %zu)\n", n_in, out_size, ws_size, (size_t)WS_END); grid = -1; return; }
        int dev = 0, cus = 0, per_cu = 0;
        if (hipGetDevice(&dev) != hipSuccess || hipDeviceGetAttribute(&cus, hipDeviceAttributeMultiprocessorCount, dev) != hipSuccess) { grid = -1; return; }
        if (hipFuncSetAttribute((const void*)fwd, hipFuncAttributeMaxDynamicSharedMemorySize, LDS_BYTES) != hipSuccess) { fprintf(stderr, "kernel_launch: hipFuncSetAttribute failed\n"); grid = -1; return; }
        if (hipOccupancyMaxActiveBlocksPerMultiprocessor(&per_cu, (const void*)fwd, NWAVES * 64, LDS_BYTES) != hipSuccess || per_cu < 1) fprintf(stderr, "kernel_launch: occupancy query says %d\n", per_cu);
        (void)hipGetLastError();
        grid = cus;
    }
    if (grid < 0) return;
    (void)hipMemsetAsync((char*)d_ws + WS_CTL, 0, CTL_ZERO_BYTES, stream);
    Args a{};
    for (int i = 0; i < 22; ++i) a.in.p[i] = (const float*)d_in[i];
    a.out = (float*)d_out; a.ws = (unsigned char*)d_ws;
#if MK_ONE_LAUNCH
    a.ph_lo = 0; a.ph_hi = NPHASE;
    hipLaunchKernelGGL(fwd, dim3(grid), dim3(NWAVES * 64), LDS_BYTES, stream, a);
#else
    for (int p = 0; p < NPHASE; ++p) { a.ph_lo = p; a.ph_hi = p + 1; hipLaunchKernelGGL(fwd, dim3(grid), dim3(NWAVES * 64), LDS_BYTES, stream, a); }
#endif
}
```

```cpp
#include <hip/hip_runtime.h>
#include <cstdio>
#include <cstdint>
#ifndef PG_WGM
#define PG_WGM 4
#endif
namespace pg8 {
#define PG8_LAS __attribute__((address_space(3)))
typedef unsigned short bf16_t;
typedef short bf16x8 __attribute__((ext_vector_type(8)));
typedef float f32x4 __attribute__((ext_vector_type(4)));
typedef unsigned u32x4 __attribute__((ext_vector_type(4)));
constexpr int BM = 256, BK = 64, HALF = 128, HTB = HALF * BK * 2  , STAGE_BYTES = 8 * HTB, NXCD = 8, WGM = PG_WGM;

__host__ __device__ __forceinline__ int lds_byte(int r, int c) { const int st = (r >> 4) * 2 + (c >> 5), rr = r & 15, cc = c & 31, ob = rr * 64 + cc * 2; return st * 1024 + (ob ^ (((ob >> 9) & 1) << 5)); }
__host__ __device__ __forceinline__ void stage_rc(int b, int& R, int& C) { const int st = b / 1024, sb = b % 1024, swz = sb ^ (((sb >> 9) & 1) << 5); R = (st >> 1) * 16 + swz / 64; C = (st & 1) * 32 + (swz % 64) / 2; }
__host__ __device__ __forceinline__ int perm32(int rho) { const int n = rho >> 4, i = rho & 15; return 8 * (i >> 2) + 4 * n + (i & 3); }

struct Unit { int pm, pn; };
struct Gemm { const bf16_t* A; const bf16_t* Bt; int M, N, K; };

struct StaticOrder {
    int nM, nN, nwg, G, c;
    __host__ __device__ void init(int M, int N, int G_, int c_) { nM = M / BM; nN = N / BM; nwg = nM * nN; G = G_; c = c_; }
    __host__ __device__ bool next(int i, Unit& u) const {
        const long L = (long)i * G + c; if (L >= nwg) return false;
        int wgid = (int)L; { const int q = nwg / NXCD, r = nwg % NXCD, xcd = wgid % NXCD, off = wgid / NXCD; wgid = (xcd < r ? xcd * (q + 1) : r * (q + 1) + (xcd - r) * q) + off; }
        const int nig = WGM * nN, gid = wgid / nig, fm = gid * WGM, gsz = (nM - fm) < WGM ? (nM - fm) : WGM;
        u.pm = fm + ((wgid % nig) % gsz); u.pn = (wgid % nig) / gsz; return true;
    }
    __device__ __forceinline__ void a_ready(const Unit&) const {}
    __device__ __forceinline__ void done(const Unit&) const {}
};


__device__ __forceinline__ unsigned cvt_pk_bf16(float lo, float hi) { unsigned r; asm volatile("v_cvt_pk_bf16_f32 %0, %1, %2" : "=v"(r) : "v"(lo), "v"(hi)); return r; }
typedef float f32x2 __attribute__((ext_vector_type(2)));
#ifndef NT_STORE
#define NT_STORE 0
#endif
__device__ __forceinline__ f32x2 gelu_pk(f32x2 v) {
    const f32x2 av = __builtin_elementwise_abs(v), d = av * 0.2316418882f + 1.0f;
    f32x2 t; t.x = __builtin_amdgcn_rcpf(d.x); t.y = __builtin_amdgcn_rcpf(d.y);
    f32x2 q = t * 0.5307027145f + (-0.7265760135f); q = q * t + 0.7107068705f; q = q * t + (-0.142248368f); q = q * t + 0.127414796f; q = q * t;
    const f32x2 s = (v * v) * (-0.72134752044f);
    f32x2 e; e.x = __builtin_amdgcn_exp2f(s.x); e.y = __builtin_amdgcn_exp2f(s.y);
    const f32x2 m = v * (q * e), r = v - m;
    f32x2 o; o.x = v.x < 0.f ? m.x : r.x; o.y = v.y < 0.f ? m.y : r.y; return o;
}
__device__ __forceinline__ float sigmoid_f(float x) { return __builtin_amdgcn_rcpf(1.0f + __builtin_amdgcn_exp2f(-1.4426950408889634f * x)); }
__device__ __forceinline__ float silu_f(float x) { return x * sigmoid_f(x); }

__host__ __device__ __forceinline__ int rs_slot(int row) { const int pm = row >> 8, r = row & 255; return (((pm * 2 + ((r >> 6) & 1)) * 16 + (r & 15)) * 8) + ((r >> 7) * 4) + ((r >> 4) & 3); }
__device__ __forceinline__ float rs_get(const u32x4& w, int i) { const unsigned x = (i >> 1) == 0 ? w.x : (i >> 1) == 1 ? w.y : (i >> 1) == 2 ? w.z : w.w; const unsigned short h = (unsigned short)((i & 1) ? (x >> 16) : (x & 0xffffu)); return (float)__builtin_bit_cast(_Float16, h); }
struct EpiF32 {
    static constexpr bool PERM = false, AFTER_DRAIN = false, ROWSCALE = false;
    float* C; int ldc;
    __device__ __forceinline__ void operator()(const f32x4 (&acc)[2][2][4][2], const Unit& u, int wr, int wc, int fr, int fq) const {
        const int row0 = u.pm * BM + wr * 64 + fr, col0 = u.pn * BM + wc * 32 + 4 * fq;
#pragma unroll
        for (int ai = 0; ai < 2; ++ai)
#pragma unroll
            for (int m = 0; m < 4; ++m) { float* rowp = C + (size_t)(row0 + ai * HALF + m * 16) * ldc + col0;
#pragma unroll
                for (int bj = 0; bj < 2; ++bj)
#pragma unroll
                    for (int n = 0; n < 2; ++n) *(f32x4*)(rowp + bj * HALF + n * 16) = acc[ai][bj][m][n]; }
    }
};
struct EpiGateMul {
    static constexpr bool PERM = false, AFTER_DRAIN = false, ROWSCALE = false;
    float* C; int ldc;
    __device__ __forceinline__ void operator()(const f32x4 (&acc)[2][2][4][2], const Unit& u, int wr, int wc, int fr, int fq) const {
        const int row0 = u.pm * BM + wr * 64 + fr, col0 = u.pn * BM + wc * 32 + 4 * fq;
#pragma unroll
        for (int ai = 0; ai < 2; ++ai)
#pragma unroll
            for (int m = 0; m < 4; ++m) { float* rowp = C + (size_t)(row0 + ai * HALF + m * 16) * ldc + col0;
#pragma unroll
                for (int bj = 0; bj < 2; ++bj)
#pragma unroll
                    for (int n = 0; n < 2; ++n) { f32x4 e = *(const f32x4*)(rowp + bj * HALF + n * 16); const f32x4 a = acc[ai][bj][m][n];
                        e[0] *= sigmoid_f(a[0]); e[1] *= sigmoid_f(a[1]); e[2] *= sigmoid_f(a[2]); e[3] *= sigmoid_f(a[3]);
                        *(f32x4*)(rowp + bj * HALF + n * 16) = e; } }
    }
};
template <int ACT, bool RS = false> struct EpiBf16 {
    static constexpr bool PERM = true, AFTER_DRAIN = false, ROWSCALE = RS;
    bf16_t* O; int ldc; int nt; const float* rs;
    __device__ __forceinline__ void prefetch(u32x4& rsv, const Unit& u, int wr, int fr) const { rsv = *(const u32x4*)((const unsigned short*)rs + ((u.pm * 2 + wr) * 16 + fr) * 8); }
    __device__ __forceinline__ void operator()(const f32x4 (&acc)[2][2][4][2], const Unit& u, int wr, int wc, int fr, int fq) const { const u32x4 one = {0x3c003c00u, 0x3c003c00u, 0x3c003c00u, 0x3c003c00u}; (*this)(acc, u, wr, wc, fr, fq, one); }
    __device__ __forceinline__ void operator()(const f32x4 (&acc)[2][2][4][2], const Unit& u, int wr, int wc, int fr, int fq, const u32x4& rsv) const {
        const int row0 = u.pm * BM + wr * 64 + fr, col0 = u.pn * BM + wc * 32 + 8 * fq;
#pragma unroll
        for (int ai = 0; ai < 2; ++ai)
#pragma unroll
            for (int m = 0; m < 4; ++m) { bf16_t* rowp = O + (size_t)(row0 + ai * HALF + m * 16) * ldc + col0; const float sc = rs_get(rsv, ai * 4 + m);
#pragma unroll
                for (int bj = 0; bj < 2; ++bj) { f32x4 v0 = acc[ai][bj][m][0], v1 = acc[ai][bj][m][1];
                    if (RS) { v0 = v0 * sc; v1 = v1 * sc; }
                    if (ACT == 1) { f32x2 a = gelu_pk((f32x2){v0[0], v0[1]}), b = gelu_pk((f32x2){v0[2], v0[3]}), c = gelu_pk((f32x2){v1[0], v1[1]}), d = gelu_pk((f32x2){v1[2], v1[3]});
                        v0 = (f32x4){a.x, a.y, b.x, b.y}; v1 = (f32x4){c.x, c.y, d.x, d.y}; }
                    u32x4 w; w.x = cvt_pk_bf16(v0[0], v0[1]); w.y = cvt_pk_bf16(v0[2], v0[3]); w.z = cvt_pk_bf16(v1[0], v1[1]); w.w = cvt_pk_bf16(v1[2], v1[3]);
                    if (nt) __builtin_nontemporal_store(w, (u32x4*)(rowp + bj * HALF)); else *(u32x4*)(rowp + bj * HALF) = w; } }
    }
};

struct EpiGateMulBf16 {
    static constexpr bool PERM = true, AFTER_DRAIN = false, ROWSCALE = false;
    bf16_t* O; int ldc;
    __device__ __forceinline__ void operator()(const f32x4 (&acc)[2][2][4][2], const Unit& u, int wr, int wc, int fr, int fq) const {
        const int row0 = u.pm * BM + wr * 64 + fr, col0 = u.pn * BM + wc * 32 + 8 * fq;
#pragma unroll
        for (int ai = 0; ai < 2; ++ai)
#pragma unroll
            for (int m = 0; m < 4; ++m) { bf16_t* rowp = O + (size_t)(row0 + ai * HALF + m * 16) * ldc + col0;
#pragma unroll
                for (int bj = 0; bj < 2; ++bj) { const u32x4 ev = *(const u32x4*)(rowp + bj * HALF); const f32x4 v0 = acc[ai][bj][m][0], v1 = acc[ai][bj][m][1];
                    const unsigned e0 = ev.x, e1 = ev.y, e2 = ev.z, e3 = ev.w;
                    u32x4 w;
                    w.x = cvt_pk_bf16(__builtin_bit_cast(float, e0 << 16) * sigmoid_f(v0[0]), __builtin_bit_cast(float, e0 & 0xffff0000u) * sigmoid_f(v0[1]));
                    w.y = cvt_pk_bf16(__builtin_bit_cast(float, e1 << 16) * sigmoid_f(v0[2]), __builtin_bit_cast(float, e1 & 0xffff0000u) * sigmoid_f(v0[3]));
                    w.z = cvt_pk_bf16(__builtin_bit_cast(float, e2 << 16) * sigmoid_f(v1[0]), __builtin_bit_cast(float, e2 & 0xffff0000u) * sigmoid_f(v1[1]));
                    w.w = cvt_pk_bf16(__builtin_bit_cast(float, e3 << 16) * sigmoid_f(v1[2]), __builtin_bit_cast(float, e3 & 0xffff0000u) * sigmoid_f(v1[3]));
                    *(u32x4*)(rowp + bj * HALF) = w; } }
    }
};
struct EpiSwiGLU {
    static constexpr bool PERM = true, AFTER_DRAIN = false, ROWSCALE = true;
    bf16_t* O; int ldc; const float* rs;
    __device__ __forceinline__ void prefetch(u32x4& rsv, const Unit& u, int wr, int fr) const { rsv = *(const u32x4*)((const unsigned short*)rs + ((u.pm * 2 + wr) * 16 + fr) * 8); }
    __device__ __forceinline__ void operator()(const f32x4 (&acc)[2][2][4][2], const Unit& u, int wr, int wc, int fr, int fq, const u32x4& rsv) const {
        const int row0 = u.pm * BM + wr * 64 + fr, col0 = u.pn * HALF + wc * 32 + 8 * fq;
#pragma unroll
        for (int ai = 0; ai < 2; ++ai)
#pragma unroll
            for (int m = 0; m < 4; ++m) { bf16_t* rowp = O + (size_t)(row0 + ai * HALF + m * 16) * ldc + col0; const float sc = rs_get(rsv, ai * 4 + m);
                const f32x4 g0 = acc[ai][0][m][0] * sc, g1 = acc[ai][0][m][1] * sc, u0 = acc[ai][1][m][0] * sc, u1 = acc[ai][1][m][1] * sc;
                u32x4 w; w.x = cvt_pk_bf16(silu_f(g0[0]) * u0[0], silu_f(g0[1]) * u0[1]); w.y = cvt_pk_bf16(silu_f(g0[2]) * u0[2], silu_f(g0[3]) * u0[3]);
                w.z = cvt_pk_bf16(silu_f(g1[0]) * u1[0], silu_f(g1[1]) * u1[1]); w.w = cvt_pk_bf16(silu_f(g1[2]) * u1[2], silu_f(g1[3]) * u1[3]);
                *(u32x4*)rowp = w; }
    }
};

template <class Epi, class Sched, bool ALIGN_EPI = false, bool SP2 = false, bool NOEPI = false>
__device__ __forceinline__ void gemm_phase(PG8_LAS unsigned char* lds, const Gemm g, const Sched& S, const Epi& E) {
    int tid_ = threadIdx.x; asm volatile("" : "+v"(tid_));
    const int tid = tid_, wid = __builtin_amdgcn_readfirstlane(tid >> 6), lane = tid & 63, wr = wid >> 2, wc = wid & 3, fr = lane & 15, fq = lane >> 4;
    const int K = g.K, nt = K / BK;
    unsigned voffA[2], voffB[2];
#pragma unroll
    for (int i = 0; i < 2; ++i) { int R, C; stage_rc(tid * 16 + i * 8192, R, C); const int Rb = Epi::PERM ? ((R & ~31) + perm32(R & 31)) : R;
        voffA[i] = (unsigned)(R * K + C) * 2u; voffB[i] = (unsigned)(Rb * K + C) * 2u; }
    const size_t kstep = (size_t)(BK * 2);
    const size_t hstep = (size_t)HALF * K * 2;
    const size_t tstep = 2 * hstep;
    const unsigned ldsw = (unsigned)wid * 1024u;
    const int aoff = lds_byte(wr * 64 + fr, fq * 8), boff = lds_byte(wc * 32 + fr, fq * 8);
#define PG8_SA(b, h) (((b) * 2 + (h)) * HTB)
#define PG8_SB(b, h) ((4 + (b) * 2 + (h)) * HTB)
#define PG8_STAGE(bufoff, gbase, voff) do { _Pragma("unroll") for (int _i = 0; _i < 2; ++_i) \
        __builtin_amdgcn_global_load_lds((const unsigned*)((const char*)(gbase) + (voff)[_i]), (PG8_LAS unsigned*)(lds + (bufoff) + ldsw + _i * 8192), 16, 0, 0); } while (0)
#define PG8_LDA(dst, b, h) do { _Pragma("unroll") for (int m = 0; m < 4; ++m) _Pragma("unroll") for (int k = 0; k < 2; ++k) dst[m][k] = *(const PG8_LAS bf16x8*)(lds + PG8_SA(b, h) + aoff + m * 2048 + k * 1024); } while (0)
#define PG8_LDB(dst, b, h) do { _Pragma("unroll") for (int n = 0; n < 2; ++n) _Pragma("unroll") for (int k = 0; k < 2; ++k) dst[n][k] = *(const PG8_LAS bf16x8*)(lds + PG8_SB(b, h) + boff + n * 2048 + k * 1024); } while (0)
#define PG8_MMA(ai, bj, At, Bt) do { __builtin_amdgcn_s_setprio(1); _Pragma("unroll") for (int m = 0; m < 4; ++m) _Pragma("unroll") for (int n = 0; n < 2; ++n) _Pragma("unroll") for (int k = 0; k < 2; ++k) \
        acc[ai][bj][m][n] = __builtin_amdgcn_mfma_f32_16x16x32_bf16(Bt[n][k], At[m][k], acc[ai][bj][m][n], 0, 0, 0); __builtin_amdgcn_s_setprio(0); } while (0)
#define PG8_WAIT_V(n) asm volatile("s_waitcnt vmcnt(" #n ")" ::: "memory")
#define PG8_WAIT_L(n) asm volatile("s_waitcnt lgkmcnt(" #n ")" ::: "memory")
#define PG8_BAR __builtin_amdgcn_s_barrier()
#define PG8_SCHED __builtin_amdgcn_sched_barrier(0)
    Unit cur, nxt; int ui = 0;
    if (!S.next(0, cur)) return;
    f32x4 acc[2][2][4][2];
#pragma unroll
    for (int a = 0; a < 2; ++a)
#pragma unroll
        for (int b = 0; b < 2; ++b)
#pragma unroll
            for (int m = 0; m < 4; ++m)
#pragma unroll
                for (int n = 0; n < 2; ++n) acc[a][b][m][n] = (f32x4){0.f, 0.f, 0.f, 0.f};
    bf16x8 At[4][2], B0[2][2], B1[2][2];
    u32x4 rsv;
    const char* cA = (const char*)g.A + (size_t)cur.pm * tstep; const char* cB = (const char*)g.Bt + (size_t)cur.pn * tstep;
    S.a_ready(cur);
    if constexpr (SP2) {
        PG8_STAGE(PG8_SB(0, 0), cB, voffB); PG8_STAGE(PG8_SB(0, 1), cB + hstep, voffB); PG8_STAGE(PG8_SA(0, 0), cA, voffA); PG8_STAGE(PG8_SA(0, 1), cA + hstep, voffA);
        if (wr == 1) PG8_BAR;
        PG8_WAIT_V(2); PG8_BAR;
        PG8_STAGE(PG8_SB(1, 0), cB + kstep, voffB); PG8_STAGE(PG8_SA(1, 0), cA + kstep, voffA); PG8_STAGE(PG8_SB(1, 1), cB + hstep + kstep, voffB);
        PG8_WAIT_V(6); PG8_BAR;
    } else {
        PG8_STAGE(PG8_SB(0, 0), cB, voffB); PG8_STAGE(PG8_SA(0, 0), cA, voffA); PG8_STAGE(PG8_SB(0, 1), cB + hstep, voffB); PG8_STAGE(PG8_SA(0, 1), cA + hstep, voffA);
        if (wr == 1) PG8_BAR;
        PG8_WAIT_V(4); PG8_BAR;
        PG8_STAGE(PG8_SB(1, 0), cB + kstep, voffB); PG8_STAGE(PG8_SA(1, 0), cA + kstep, voffA); PG8_STAGE(PG8_SB(1, 1), cB + hstep + kstep, voffB);
        PG8_WAIT_V(6); PG8_BAR;
    }
    for (;;) {
        const bool has_next = S.next(ui + 1, nxt);
        const char* nA = has_next ? (const char*)g.A + (size_t)nxt.pm * tstep : cA; const char* nB = has_next ? (const char*)g.Bt + (size_t)nxt.pn * tstep : cB;
        for (int t = 0; t < nt; t += 2) {
            const bool last = (t == nt - 2);
            const char* a1 = cA + (size_t)(t + 1) * kstep;
            const char* a2 = last ? nA : cA + (size_t)(t + 2) * kstep; const char* b2 = last ? nB : cB + (size_t)(t + 2) * kstep;
            const char* a3 = a2 + kstep; const char* b3 = b2 + kstep;
            if (last && has_next) S.a_ready(nxt);
            if constexpr (Epi::ROWSCALE) { if (last) E.prefetch(rsv, cur, wr, fr); }
            if constexpr (SP2) {
            PG8_LDB(B0, 0, 0); PG8_LDB(B1, 0, 1); PG8_SCHED; PG8_LDA(At, 0, 0); PG8_STAGE(PG8_SA(1, 1), a1 + hstep, voffA);
            PG8_WAIT_V(8); PG8_WAIT_L(0); PG8_BAR; PG8_MMA(0, 0, At, B0); PG8_MMA(0, 1, At, B1); PG8_BAR; PG8_SCHED;
            PG8_LDA(At, 0, 1); PG8_STAGE(PG8_SB(0, 0), b2, voffB); PG8_STAGE(PG8_SB(0, 1), b2 + hstep, voffB); PG8_STAGE(PG8_SA(0, 0), a2, voffA);
            PG8_WAIT_V(8); PG8_WAIT_L(0); PG8_BAR; PG8_MMA(1, 0, At, B0); PG8_MMA(1, 1, At, B1); PG8_BAR; PG8_SCHED;
            PG8_LDB(B0, 1, 0); PG8_LDB(B1, 1, 1); PG8_SCHED; PG8_LDA(At, 1, 0); PG8_STAGE(PG8_SA(0, 1), a2 + hstep, voffA);
            PG8_WAIT_V(8); PG8_WAIT_L(0); PG8_BAR; PG8_MMA(0, 0, At, B0); PG8_MMA(0, 1, At, B1); PG8_BAR; PG8_SCHED;
            PG8_LDA(At, 1, 1); PG8_STAGE(PG8_SB(1, 0), b3, voffB); PG8_STAGE(PG8_SB(1, 1), b3 + hstep, voffB); PG8_STAGE(PG8_SA(1, 0), a3, voffA);
            PG8_WAIT_V(8); PG8_WAIT_L(0); PG8_BAR; PG8_MMA(1, 0, At, B0); PG8_MMA(1, 1, At, B1); PG8_BAR; PG8_SCHED;
            } else {
            PG8_LDB(B0, 0, 0); PG8_SCHED; PG8_LDA(At, 0, 0); PG8_STAGE(PG8_SA(1, 1), a1 + hstep, voffA);
            PG8_WAIT_L(8); PG8_BAR; PG8_WAIT_L(0); PG8_MMA(0, 0, At, B0); PG8_BAR; PG8_SCHED;
            PG8_LDB(B1, 0, 1); PG8_STAGE(PG8_SB(0, 0), b2, voffB);
            PG8_BAR; PG8_WAIT_L(0); PG8_MMA(0, 1, At, B1); PG8_BAR;
            PG8_LDA(At, 0, 1); PG8_STAGE(PG8_SA(0, 0), a2, voffA);
            PG8_BAR; PG8_WAIT_L(0); PG8_MMA(1, 0, At, B0); PG8_BAR; PG8_SCHED;
            PG8_STAGE(PG8_SB(0, 1), b2 + hstep, voffB);
            PG8_WAIT_V(6); PG8_BAR; PG8_MMA(1, 1, At, B1); PG8_BAR;
            PG8_LDB(B0, 1, 0); PG8_SCHED; PG8_LDA(At, 1, 0); PG8_STAGE(PG8_SA(0, 1), a2 + hstep, voffA);
            PG8_WAIT_L(8); PG8_BAR; PG8_WAIT_L(0); PG8_MMA(0, 0, At, B0); PG8_BAR; PG8_SCHED;
            PG8_LDB(B1, 1, 1); PG8_STAGE(PG8_SB(1, 0), b3, voffB);
            PG8_BAR; PG8_WAIT_L(0); PG8_MMA(0, 1, At, B1); PG8_BAR;
            PG8_LDA(At, 1, 1); PG8_STAGE(PG8_SA(1, 0), a3, voffA);
            PG8_BAR; PG8_WAIT_L(0); PG8_MMA(1, 0, At, B0); PG8_BAR; PG8_SCHED;
            PG8_STAGE(PG8_SB(1, 1), b3 + hstep, voffB);
            PG8_WAIT_V(6); PG8_BAR; PG8_MMA(1, 1, At, B1); PG8_BAR;
            }
        }
        if constexpr (ALIGN_EPI) { if (wr == 0) PG8_BAR; }
        if constexpr (!Epi::AFTER_DRAIN && !NOEPI) { if constexpr (Epi::ROWSCALE) E(acc, cur, wr, wc, fr, fq, rsv); else E(acc, cur, wr, wc, fr, fq); S.done(cur); }
        if constexpr (NOEPI) { f32x4 sacc = (f32x4){0.f, 0.f, 0.f, 0.f};
#pragma unroll
            for (int a = 0; a < 2; ++a)
#pragma unroll
                for (int bb = 0; bb < 2; ++bb)
#pragma unroll
                    for (int m = 0; m < 4; ++m)
#pragma unroll
                        for (int n = 0; n < 2; ++n) sacc += acc[a][bb][m][n];
            asm volatile("" :: "v"(sacc)); }
        if (!has_next) break;
#pragma unroll
        for (int a = 0; a < 2; ++a)
#pragma unroll
            for (int b = 0; b < 2; ++b)
#pragma unroll
                for (int m = 0; m < 4; ++m)
#pragma unroll
                    for (int n = 0; n < 2; ++n) acc[a][b][m][n] = (f32x4){0.f, 0.f, 0.f, 0.f};
        cur = nxt; cA = nA; cB = nB; ++ui;
        if constexpr (ALIGN_EPI) { if (wr == 1) PG8_BAR; }
    }
    PG8_WAIT_V(0);
    if constexpr (!ALIGN_EPI) { if (wr == 0) PG8_BAR; }
    PG8_BAR;
    if constexpr (Epi::AFTER_DRAIN) { E.fused(acc, cur, wr, wc, fr, fq, lds, wid, lane); S.done(cur); }
#undef PG8_SA
#undef PG8_SB
#undef PG8_STAGE
#undef PG8_LDA
#undef PG8_LDB
#undef PG8_MMA
#undef PG8_WAIT_V
#undef PG8_WAIT_L
#undef PG8_BAR
#undef PG8_SCHED
}
}
#define GAS __attribute__((address_space(1)))
#define LAS __attribute__((address_space(3)))
typedef unsigned short bf16;
typedef unsigned v4u __attribute__((ext_vector_type(4)));
typedef float f32x4 __attribute__((ext_vector_type(4)));
typedef short bf16x8 __attribute__((ext_vector_type(8)));
typedef GAS unsigned gu32;
typedef GAS unsigned long long gu64;
#define RLX_AGENT __ATOMIC_RELAXED, __HIP_MEMORY_SCOPE_AGENT
#define LDS_WAIT() asm volatile("s_waitcnt lgkmcnt(0)" ::: "memory")
#define VM_WAIT() asm volatile("s_waitcnt vmcnt(0)" ::: "memory")
__device__ __forceinline__ unsigned long long rt() { return __builtin_amdgcn_s_memrealtime(); }
__device__ __forceinline__ unsigned f2bf(float f) { unsigned u = __builtin_bit_cast(unsigned, f); return (u + 0x7fffu + ((u >> 16) & 1u)) >> 16; }
__device__ __forceinline__ unsigned pk2(float lo, float hi) { return f2bf(lo) | (f2bf(hi) << 16); }

#define XB_TMO      128
#define XB_XCNT(j)  (256  + 64 * (j))
#define XB_XSUB(j)  (1280 + 64 * (j))
#define XB_XGEN(j)  (2304 + 64 * (j))
#define XB_TOP      3328
#define XB_TOPGEN   3392
#define XCD_BAR_WORDS 3456
#define XB_SPIN_CAP (1u << 18)

__device__ __forceinline__ unsigned xb_ld(unsigned* p)              { return __hip_atomic_load(p, __ATOMIC_RELAXED, __HIP_MEMORY_SCOPE_AGENT); }
__device__ __forceinline__ unsigned xb_add(unsigned* p, unsigned v) { return __hip_atomic_fetch_add(p, v, __ATOMIC_RELAXED, __HIP_MEMORY_SCOPE_AGENT); }
__device__ __forceinline__ unsigned xb_xcc_id() { return (unsigned)__builtin_amdgcn_s_getreg((3 << 11) | 20) & 0xFu; }
#define XB_SPIN(cond, bar) do { unsigned _sp = 0; while (cond) { __builtin_amdgcn_s_sleep(1); \
    if ((++_sp & 255u) == 0u) { if (xb_ld(&(bar)[XB_TMO])) break; if (_sp > XB_SPIN_CAP) { atomicAdd(&(bar)[XB_TMO], 1u); break; } } } } while (0)

struct XcdBarrier {
    unsigned* bar; unsigned x;
    volatile LAS unsigned* st;
};

__device__ __forceinline__ XcdBarrier xcd_barrier_post(unsigned* bar, volatile LAS unsigned* st) {
    XcdBarrier b; b.bar = bar; b.x = xb_xcc_id(); b.st = st;
    if (threadIdx.x == 0) (void)xb_add(&bar[XB_XCNT(b.x)], 1u);
    return b;
}
__device__ __forceinline__ void xcd_barrier_complete(unsigned* bar, unsigned x, unsigned& nloc, unsigned& nx) {
    const unsigned G = gridDim.x * gridDim.y * gridDim.z;
    unsigned sum, cnt, mine, sp = 0u;
    for (;;) {
        sum = 0u; cnt = 0u; mine = 0u;
#pragma unroll
        for (unsigned j = 0; j < 16; ++j) { const unsigned c = xb_ld(&bar[XB_XCNT(j)]); sum += c; cnt += (c > 0u) ? 1u : 0u; mine = (j == x) ? c : mine; }
        if (sum == G) break;
        __builtin_amdgcn_s_sleep(1);
        if ((++sp & 255u) == 0u) { if (xb_ld(&bar[XB_TMO])) break; if (sp > XB_SPIN_CAP) { atomicAdd(&bar[XB_TMO], 1u); break; } }
    }
    nloc = mine > 0u ? mine : 1u; nx = cnt > 0u ? cnt : 1u;
}

__device__ __forceinline__ void xcd_barrier(const XcdBarrier& b) {
    asm volatile("s_waitcnt vmcnt(0)" ::: "memory");
    __syncthreads();
    if (threadIdx.x == 0) {
        unsigned* bar = b.bar;
        __builtin_amdgcn_s_waitcnt(0);
        unsigned nloc = b.st[0], nx = b.st[1];
        if (nloc == 0u) { xcd_barrier_complete(bar, b.x, nloc, nx); b.st[0] = nloc; b.st[1] = nx; }
        const unsigned old = xb_add(&bar[XB_XSUB(b.x)], 1u);
        const unsigned gen = old / nloc;
        if (old + 1u == (gen + 1u) * nloc) {
            __builtin_amdgcn_fence(__ATOMIC_RELEASE, "agent");
            asm volatile("s_waitcnt vmcnt(0)" ::: "memory");
            const unsigned og = xb_add(&bar[XB_TOP], 1u);
            const unsigned tg = og / nx;
            if (og + 1u == (tg + 1u) * nx) xb_add(&bar[XB_TOPGEN], 1u);
            else XB_SPIN(xb_ld(&bar[XB_TOPGEN]) == tg, bar);
            __builtin_amdgcn_fence(__ATOMIC_ACQUIRE, "agent");
            xb_add(&bar[XB_XGEN(b.x)], 1u);
            asm volatile("s_waitcnt vmcnt(0)" ::: "memory");
        } else {
            XB_SPIN(xb_ld(&bar[XB_XGEN(b.x)]) == gen, bar);
            __builtin_amdgcn_fence(__ATOMIC_ACQUIRE, "agent");
            asm volatile("s_waitcnt vmcnt(0)" ::: "memory");
        }
    }
    __syncthreads();
}


constexpr int NWAVES = 8;
constexpr int BATCH = 16, SEQ = 2048, D = 2048, DEPTH = 4, M = BATCH * SEQ;
constexpr int HG_PROJ = 8192, HG_HEADS = 16, HG_K = 128;
constexpr int GM_PROJ = 4096, GM_G = 16, GM_C = 128;
constexpr int FF = 5632, PLE = 256;
constexpr float EPS = 1e-6f;
constexpr int NPHASE = 1 + 9 * DEPTH;

#ifndef DIS_GMLP
#define DIS_GMLP 0
#endif
#ifndef DIS_HGRN
#define DIS_HGRN 0
#endif
#ifndef DIS_THIN
#define DIS_THIN 0
#endif
#ifndef NLOOP
#define NLOOP DEPTH
#endif
#ifndef DUP_MASK
#define DUP_MASK 0
#endif
#define DUP(n) (((DUP_MASK) >> (n)) & 1)
#ifndef HG_FILTER
#define HG_FILTER(t0, t) true
#endif
#ifndef HG_BOTH
#define HG_BOTH 0
#endif
#ifndef PG_ALIGN
#define PG_ALIGN true
#endif
#ifndef PG_SP2
#define PG_SP2 true
#endif
#ifndef THIN_NT
#define THIN_NT 1
#endif
#ifndef NT_G1H
#define NT_G1H 0
#endif
#ifndef NT_G1G
#define NT_G1G 0
#endif
#ifndef GMLP_NAIVE
#define GMLP_NAIVE 0
#endif
#ifndef HGRN_NAIVE
#define HGRN_NAIVE 0
#endif
#ifndef EN_MASK
#define EN_MASK 0xff
#endif
#define EN(n) (((EN_MASK) >> (n)) & 1)
#ifndef MK_ONE_LAUNCH
#define MK_ONE_LAUNCH 1
#endif

constexpr size_t MiB = 1u << 20;
constexpr size_t WS_CTL = 0, CTL_ZERO_BYTES = 65536;
constexpr size_t WS_W1 = 1 * MiB;
constexpr size_t WS_W2 = 33 * MiB;
constexpr size_t WS_WGU = 41 * MiB;
constexpr size_t WS_WD = 85 * MiB;
constexpr size_t WS_WPG = 107 * MiB;
constexpr size_t WS_WPP = 115 * MiB;
constexpr size_t WS_PB = 116 * MiB;
constexpr size_t WS_WST = 132 * MiB;
constexpr size_t WS_WSB = 133 * MiB;
constexpr size_t WS_RS = 133 * MiB + 512 * 1024;
constexpr size_t WS_A = 134 * MiB;
constexpr size_t WS_BIG = 262 * MiB;
constexpr size_t WS_MO = 774 * MiB;
constexpr size_t WS_END = 1030 * MiB;
constexpr int CW_BAR = 4096;

constexpr int RING_OFF = 0, RING_BYTES = 131072;
constexpr int LDSCTL_OFF = RING_BYTES, MISC_OFF = LDSCTL_OFF + 320, XTRA_OFF = LDSCTL_OFF + 1024;
constexpr int LDS_BYTES = 147456;

typedef unsigned v2u __attribute__((ext_vector_type(2)));
#if LBAR_SYNC
#define LBAR() __syncthreads()
#else
#define LBAR() do { asm volatile("s_waitcnt lgkmcnt(0)" ::: "memory"); __builtin_amdgcn_s_barrier(); asm volatile("" ::: "memory"); } while (0)
#endif
__device__ __forceinline__ float wave_sum(float v) {
#pragma unroll
    for (int o = 1; o < 64; o <<= 1) v += __shfl_xor(v, o);
    return v;
}
__device__ __forceinline__ float dot4(f32x4 a) { return (a.x * a.x + a.y * a.y) + (a.z * a.z + a.w * a.w); }
__device__ __forceinline__ float bf2f(unsigned short b) { return __builtin_bit_cast(float, ((unsigned)b) << 16); }
__device__ __forceinline__ float bfw(unsigned w, int hi) { return __builtin_bit_cast(float, hi ? (w & 0xffff0000u) : (w << 16)); }
__device__ __forceinline__ float sigm(float x) { return 1.0f / (1.0f + __expf(-x)); }

struct TItem { const float* W; bf16* WT; int K, N, mode, item; const float* ks; };
__device__ __forceinline__ void titem_load(const TItem& t, float (&v)[32], int lane) {
    const int nblk = t.N / 32, kb = t.item / nblk, nb = t.item % nblk, k0 = 64 * kb, n0 = 32 * nb;
    const float* src = t.W + (size_t)(k0 + (lane >> 5)) * t.N + n0 + (lane & 31);
#pragma unroll
    for (int i = 0; i < 32; ++i) v[i] = *(const GAS float*)(src + (size_t)(2 * i) * t.N);
}
__device__ __forceinline__ void titem_finish(const TItem& t, const float (&v)[32], LAS float* scr, int lane) {
    const int nblk = t.N / 32, kb = t.item / nblk, nb = t.item % nblk, k0 = 64 * kb, n0 = 32 * nb;
    const int d0 = t.mode == 0 ? n0 : ((n0 >> 7) * 256 + (n0 & 127) + (t.mode == 2 ? 128 : 0));
#pragma unroll
    for (int i = 0; i < 32; ++i) scr[(2 * i + (lane >> 5)) * 33 + (lane & 31)] = v[i];
    LDS_WAIT(); asm volatile("" ::: "memory");
    const int c = lane & 7;
    f32x4 ks0 = (f32x4){1.f, 1.f, 1.f, 1.f}, ks1 = ks0;
    if (t.ks) { ks0 = *(const GAS f32x4*)(t.ks + k0 + 8 * c); ks1 = *(const GAS f32x4*)(t.ks + k0 + 8 * c + 4); }
#pragma unroll
    for (int j = 0; j < 4; ++j) { const int n = (lane >> 3) + 8 * j; const LAS float* s = scr + (8 * c) * 33 + n;
        v4u o; o.x = pk2(s[0 * 33] * ks0.x, s[1 * 33] * ks0.y); o.y = pk2(s[2 * 33] * ks0.z, s[3 * 33] * ks0.w); o.z = pk2(s[4 * 33] * ks1.x, s[5 * 33] * ks1.y); o.w = pk2(s[6 * 33] * ks1.z, s[7 * 33] * ks1.w);
        *(GAS v4u*)(t.WT + (size_t)(d0 + n) * t.K + k0 + 8 * c) = o; }
    LDS_WAIT(); asm volatile("" ::: "memory");
}

struct In { const float* p[22]; };

__device__ __forceinline__ void convert_layer(const In& in, unsigned char* ws, int L, LAS unsigned char* lds, int gw, int NGW, int wave, int lane) {
    asm volatile("" : "+v"(lane));
    LAS float* scr = (LAS float*)(lds + RING_OFF + wave * 16384);
    const int j = L >> 1;
    const bool odd = (L & 1) != 0;
    const float* w1 = odd ? in.p[6] + (size_t)j * D * GM_PROJ : in.p[2] + (size_t)j * D * HG_PROJ;
    const int n1 = odd ? GM_PROJ : HG_PROJ;
    const float* w2 = odd ? in.p[11] + (size_t)j * D * D : in.p[5] + (size_t)j * D * D;
    const float* wg = in.p[16] + (size_t)L * D * FF; const float* wu = in.p[17] + (size_t)L * D * FF; const float* wd = in.p[18] + (size_t)L * FF * D;
    const float* wpp = in.p[19] + (size_t)L * PLE * D; const float* wpg = in.p[20] + (size_t)L * D * D;
    const int I1 = (D / 64) * (n1 / 32), I2 = (D / 64) * (D / 32), IG = (D / 64) * (FF / 32), ID = (FF / 64) * (D / 32), IPP = (PLE / 64) * (D / 32);
    const int NITEMS = I1 + I2 + 2 * IG + ID + I2 + IPP;
#define CV_ITEM(t, it_) do { int r = (it_); \
        if (r < I1) { t = TItem{w1, (bf16*)(ws + WS_W1), D, n1, 0, r, in.p[12] + L * D}; break; } r -= I1; \
        if (r < I2) { t = TItem{w2, (bf16*)(ws + WS_W2), D, D, 0, r, nullptr}; break; } r -= I2; \
        if (r < IG) { t = TItem{wg, (bf16*)(ws + WS_WGU), D, FF, 1, r, in.p[14] + L * D}; break; } r -= IG; \
        if (r < IG) { t = TItem{wu, (bf16*)(ws + WS_WGU), D, FF, 2, r, in.p[14] + L * D}; break; } r -= IG; \
        if (r < ID) { t = TItem{wd, (bf16*)(ws + WS_WD), FF, D, 0, r, nullptr}; break; } r -= ID; \
        if (r < I2) { t = TItem{wpg, (bf16*)(ws + WS_WPG), D, D, 0, r, nullptr}; break; } r -= I2; \
        t = TItem{wpp, (bf16*)(ws + WS_WPP), PLE, D, 0, r, nullptr}; } while (0)
    for (int it = gw; it < NITEMS; it += 2 * NGW) {
        TItem t0, t1; float v0[32], v1[32]; const bool has1 = (it + NGW < NITEMS);
        CV_ITEM(t0, it); titem_load(t0, v0, lane);
        if (has1) { CV_ITEM(t1, it + NGW); titem_load(t1, v1, lane); }
        titem_finish(t0, v0, scr, lane);
        if (has1) titem_finish(t1, v1, scr, lane);
    }
#undef CV_ITEM
    { const float* ps = in.p[1] + (size_t)L * M * PLE; bf16* pb = (bf16*)(ws + WS_PB);
      for (size_t i = (size_t)gw * 64 + lane; i < (size_t)M * PLE / 8; i += (size_t)NGW * 64) {
          const f32x4 a = *(const GAS f32x4*)(ps + i * 8), b = *(const GAS f32x4*)(ps + i * 8 + 4);
          v4u o; o.x = pk2(a.x, a.y); o.y = pk2(a.z, a.w); o.z = pk2(b.x, b.y); o.w = pk2(b.z, b.w);
          *(GAS v4u*)(pb + i * 8) = o; } }
    if (odd) {
        const float* wsrc = in.p[9] + (size_t)j * GM_G * GM_C * GM_C; float* wst = (float*)(ws + WS_WST);
        for (int i = gw * 64 + lane; i < GM_G * GM_C * GM_C; i += NGW * 64) { const int t = i & 127, s = (i >> 7) & 127, g = i >> 14;
            wst[i] = (s <= t) ? wsrc[(g * GM_C + t) * GM_C + s] : 0.f; }
        bf16* wsb = (bf16*)(ws + WS_WSB);
        for (int i = gw * 64 + lane; i < GM_G * GM_C * GM_C; i += NGW * 64) { const int s2 = i & 127, t2 = (i >> 7) & 127; wsb[i] = (bf16)((s2 <= t2) ? f2bf(wsrc[i]) : 0u); }
    }
}

__device__ __forceinline__ void rows_to_bf16_rs(const float* x, bf16* H, float* rs, int gw, int NGW, int lane) {
    for (int m = gw; m < M; m += NGW) {
        const GAS f32x4* xr = (const GAS f32x4*)(x + (size_t)m * D) + 2 * lane;
        f32x4 v[8]; float ss = 0.f;
#pragma unroll
        for (int j = 0; j < 4; ++j) { v[2 * j] = xr[128 * j]; v[2 * j + 1] = xr[128 * j + 1]; ss += dot4(v[2 * j]) + dot4(v[2 * j + 1]); }
        const float rstd = __builtin_amdgcn_rsqf(wave_sum(ss) * (1.f / D) + EPS);
        GAS v4u* o16 = (GAS v4u*)(H + (size_t)m * D) + lane;
#pragma unroll
        for (int j = 0; j < 4; ++j) { const f32x4 a0 = v[2 * j], a1 = v[2 * j + 1]; o16[64 * j] = (v4u){pk2(a0.x, a0.y), pk2(a0.z, a0.w), pk2(a1.x, a1.y), pk2(a1.z, a1.w)}; }
        if (lane == 0) ((_Float16*)rs)[pg8::rs_slot(m)] = (_Float16)rstd;
    }
}
struct ThinRow { f32x4 hv[8]; v4u hw[4]; v4u mw[4]; };
template <bool HIN_F32>
__device__ __forceinline__ void thin_load(ThinRow& r, const void* hin, const bf16* mo, int m, int lane) {
    const GAS v4u* mr = (const GAS v4u*)(mo + (size_t)m * D) + lane;
    if (HIN_F32) { const GAS f32x4* hr = (const GAS f32x4*)((const float*)hin + (size_t)m * D) + 2 * lane;
#pragma unroll
        for (int j = 0; j < 4; ++j) { r.mw[j] = THIN_NT ? __builtin_nontemporal_load(mr + 64 * j) : mr[64 * j]; r.hv[2 * j] = hr[128 * j]; r.hv[2 * j + 1] = hr[128 * j + 1]; } }
    else { const GAS v4u* hr = (const GAS v4u*)((const bf16*)hin + (size_t)m * D) + lane;
#pragma unroll
        for (int j = 0; j < 4; ++j) { r.mw[j] = THIN_NT ? __builtin_nontemporal_load(mr + 64 * j) : mr[64 * j]; r.hw[j] = (THIN_NT > 1) ? __builtin_nontemporal_load(hr + 64 * j) : hr[64 * j]; } }
}
template <bool HIN_F32, bool HOUT_F32, bool NORM_A>
__device__ __forceinline__ void thin_proc(ThinRow& r, const float* gpost, const float* gnext, void* hout, float* A, int m, int lane) {
    f32x4 mv[8]; float ss = 0.f;
#pragma unroll
    for (int j = 0; j < 4; ++j) { const v4u w = r.mw[j];
        mv[2 * j] = (f32x4){bfw(w.x, 0), bfw(w.x, 1), bfw(w.y, 0), bfw(w.y, 1)}; mv[2 * j + 1] = (f32x4){bfw(w.z, 0), bfw(w.z, 1), bfw(w.w, 0), bfw(w.w, 1)};
        ss += dot4(mv[2 * j]) + dot4(mv[2 * j + 1]);
        if (!HIN_F32) { const v4u hw = r.hw[j]; r.hv[2 * j] = (f32x4){bfw(hw.x, 0), bfw(hw.x, 1), bfw(hw.y, 0), bfw(hw.y, 1)}; r.hv[2 * j + 1] = (f32x4){bfw(hw.z, 0), bfw(hw.z, 1), bfw(hw.w, 0), bfw(hw.w, 1)}; } }
    const float rstd = __builtin_amdgcn_rsqf(wave_sum(ss) * (1.f / D) + EPS);
    float ss2 = 0.f;
#pragma unroll
    for (int j = 0; j < 4; ++j) {
#pragma unroll
        for (int h2 = 0; h2 < 2; ++h2) { const f32x4 gg = ((const GAS f32x4*)gpost)[2 * lane + 128 * j + h2]; r.hv[2 * j + h2] = r.hv[2 * j + h2] + mv[2 * j + h2] * rstd * gg; ss2 += dot4(r.hv[2 * j + h2]); }
        if (HOUT_F32) { GAS f32x4* ho = (GAS f32x4*)((float*)hout + (size_t)m * D) + 2 * lane; ho[128 * j] = r.hv[2 * j]; ho[128 * j + 1] = r.hv[2 * j + 1]; }
        else { GAS v4u* ho = (GAS v4u*)((bf16*)hout + (size_t)m * D) + lane; const f32x4 a0 = r.hv[2 * j], a1 = r.hv[2 * j + 1]; ho[64 * j] = (v4u){pk2(a0.x, a0.y), pk2(a0.z, a0.w), pk2(a1.x, a1.y), pk2(a1.z, a1.w)}; } }
    if (NORM_A) { const float r2 = __builtin_amdgcn_rsqf(wave_sum(ss2) * (1.f / D) + EPS); if (lane == 0) ((_Float16*)A)[pg8::rs_slot(m)] = (_Float16)r2; }
}
template <bool HIN_F32, bool HOUT_F32, bool NORM_A>
__device__ __forceinline__ void thin_phase(const void* hin, const bf16* mo, const float* gpost, const float* gnext, void* hout, float* A, int gw, int NGW, int lane) {
    asm volatile("" : "+v"(lane));
    ThinRow r0, r1;
    if (gw < M) thin_load<HIN_F32>(r0, hin, mo, gw, lane);
    for (int m = gw; m < M; m += 2 * NGW) {
        const bool has1 = (m + NGW < M);
        if (has1) thin_load<HIN_F32>(r1, hin, mo, m + NGW, lane);
        thin_proc<HIN_F32, HOUT_F32, NORM_A>(r0, gpost, gnext, hout, A, m, lane);
        if (m + 2 * NGW < M) thin_load<HIN_F32>(r0, hin, mo, m + 2 * NGW, lane);
        if (has1) thin_proc<HIN_F32, HOUT_F32, NORM_A>(r1, gpost, gnext, hout, A, m + NGW, lane);
    }
}

__device__ __forceinline__ void hgrn_naive_phase(const bf16* proj, const float* lb_logits, int j, const float* out_norm, bf16* Y, LAS unsigned char* lds, int tid, int G) {
    asm volatile("" : "+v"(tid));
    LAS float* Q = (LAS float*)(lds);
    LAS float* F = Q + 2048; LAS float* KK = F + 2048; LAS float* V = KK + 2048; LAS float* Gt = V + 2048;
    LAS float* Po = Gt + 2048;
    const int tok = tid >> 5, c4 = (tid & 31) * 4, v = tid & 127, kg = tid >> 7;
    for (int u = blockIdx.x; u < BATCH * HG_HEADS; u += G) {
        const int b = u / HG_HEADS, hd = u % HG_HEADS;
        float lb[4], lbf[4], onw[4];
#pragma unroll
        for (int i = 0; i < 4; ++i) { const int ch = hd * HG_K + c4 + i; const float l0 = lb_logits[ch], l1 = lb_logits[2048 + ch];
            lb[i] = (j == 0) ? 0.f : 1.0f / (1.0f + __expf(l0 - l1)); lbf[i] = fmaxf(lb[i], 1e-30f); onw[i] = out_norm[c4 + i]; }
        float S[32];
#pragma unroll
        for (int i = 0; i < 32; ++i) S[i] = 0.f;
        for (int t0 = 0; t0 < SEQ; t0 += 16) {
            { const size_t row = (size_t)b * SEQ + t0 + tok; const bf16* pr = proj + row * HG_PROJ + hd * HG_K + c4;
              const v2u zq = *(const GAS v2u*)(pr), zf = *(const GAS v2u*)(pr + 2048), zi = *(const GAS v2u*)(pr + 4096), zg = *(const GAS v2u*)(pr + 6144);
              const unsigned qw[2] = {zq.x, zq.y}, fw[2] = {zf.x, zf.y}, iw[2] = {zi.x, zi.y}, gw2[2] = {zg.x, zg.y};
              f32x4 qv, fv, kv, vv, gv;
#pragma unroll
              for (int i = 0; i < 4; ++i) { const float a = bfw(qw[i >> 1], i & 1); qv[i] = a * sigm(a); const float z = bfw(fw[i >> 1], i & 1); fv[i] = lbf[i] + (1.0f - lb[i]) * sigm(z); kv[i] = (1.0f - lb[i]) * sigm(-z); vv[i] = bfw(iw[i >> 1], i & 1); gv[i] = bfw(gw2[i >> 1], i & 1); }
              const int o = tok * 128 + c4;
              *(LAS f32x4*)(Q + o) = qv; *(LAS f32x4*)(F + o) = fv; *(LAS f32x4*)(KK + o) = kv; *(LAS f32x4*)(V + o) = vv; *(LAS f32x4*)(Gt + o) = gv; }
            __syncthreads();
            for (int t = 0; t < 16; ++t) {
                const float vt = V[t * 128 + v]; float po = 0.f;
#pragma unroll
                for (int i4 = 0; i4 < 8; ++i4) { const int o = t * 128 + kg * 32 + i4 * 4; const f32x4 f4 = *(const LAS f32x4*)(F + o), k4 = *(const LAS f32x4*)(KK + o), q4 = *(const LAS f32x4*)(Q + o);
#pragma unroll
                    for (int e = 0; e < 4; ++e) { S[i4 * 4 + e] = f4[e] * S[i4 * 4 + e] + k4[e] * vt; po += S[i4 * 4 + e] * q4[e]; } }
                Po[(t * 4 + kg) * 128 + v] = po;
            }
            __syncthreads();
            { f32x4 o4 = *(const LAS f32x4*)(Po + (tok * 4 + 0) * 128 + c4);
#pragma unroll
              for (int g2 = 1; g2 < 4; ++g2) o4 = o4 + *(const LAS f32x4*)(Po + (tok * 4 + g2) * 128 + c4);
              float ss = dot4(o4);
#pragma unroll
              for (int o = 1; o < 32; o <<= 1) ss += __shfl_xor(ss, o);
              const float rstd = 1.0f / sqrtf(ss * (1.f / 128.f) + EPS);
              const f32x4 gv = *(const LAS f32x4*)(Gt + tok * 128 + c4);
              float y[4];
#pragma unroll
              for (int i = 0; i < 4; ++i) y[i] = o4[i] * rstd * onw[i] * (gv[i] * sigm(gv[i]));
              const size_t row = (size_t)b * SEQ + t0 + tok;
              *(GAS unsigned long long*)(Y + row * D + hd * HG_K + c4) = (unsigned long long)pk2(y[0], y[1]) | ((unsigned long long)pk2(y[2], y[3]) << 32); }
            __syncthreads();
        }
    }
}

__device__ __forceinline__ void gmlp_naive_phase(const bf16* z, const float* ln_g, const float* ln_b, const float* wst, const float* b_s, bf16* Y, LAS unsigned char* lds, int tid, int G) {
    asm volatile("" : "+v"(tid));
    LAS float* Vn = (LAS float*)(lds);
    LAS float* WT = Vn + 16384;
    LAS float* ST = (LAS float*)(lds + XTRA_OFF);
    const int lane = tid & 63, wave = tid >> 6;
    for (int u = blockIdx.x; u < BATCH * (SEQ / GM_C); u += G) {
        const size_t row0 = (size_t)u * GM_C;
        for (int r = wave * 16; r < wave * 16 + 16; ++r) {
            const bf16* vr = z + (row0 + r) * GM_PROJ + 2048 + lane * 8;
            float x[32]; float s = 0.f;
#pragma unroll
            for (int jj = 0; jj < 4; ++jj) { const v4u w = *(const GAS v4u*)(vr + 512 * jj); const unsigned ww[4] = {w.x, w.y, w.z, w.w};
#pragma unroll
                for (int e = 0; e < 4; ++e) { x[jj * 8 + 2 * e] = __builtin_bit_cast(float, ww[e] << 16); x[jj * 8 + 2 * e + 1] = __builtin_bit_cast(float, ww[e] & 0xffff0000u); s += x[jj * 8 + 2 * e] + x[jj * 8 + 2 * e + 1]; } }
            const float mean = wave_sum(s) * (1.f / 2048.f); float q = 0.f;
#pragma unroll
            for (int e = 0; e < 32; ++e) { const float d = x[e] - mean; q += d * d; }
            const float rstd = 1.0f / sqrtf(wave_sum(q) * (1.f / 2048.f) + EPS);
            if (lane == 0) { ST[2 * r] = mean; ST[2 * r + 1] = rstd; }
        }
        __syncthreads();
        for (int g = 0; g < GM_G; ++g) {
#pragma unroll
            for (int i = 0; i < 4; ++i) { const int s = (tid >> 4) + 32 * i, c8 = (tid & 15) * 8;
                const v4u w = *(const GAS v4u*)(z + (row0 + s) * GM_PROJ + 2048 + g * GM_C + c8); const unsigned ww[4] = {w.x, w.y, w.z, w.w};
                const float mean = ST[2 * s], rstd = ST[2 * s + 1];
                const f32x4 g0 = *(const GAS f32x4*)(ln_g + g * GM_C + c8), g1 = *(const GAS f32x4*)(ln_g + g * GM_C + c8 + 4), b0 = *(const GAS f32x4*)(ln_b + g * GM_C + c8), b1 = *(const GAS f32x4*)(ln_b + g * GM_C + c8 + 4);
                f32x4 o0, o1;
                o0.x = (__builtin_bit_cast(float, ww[0] << 16) - mean) * rstd * g0.x + b0.x; o0.y = (__builtin_bit_cast(float, ww[0] & 0xffff0000u) - mean) * rstd * g0.y + b0.y;
                o0.z = (__builtin_bit_cast(float, ww[1] << 16) - mean) * rstd * g0.z + b0.z; o0.w = (__builtin_bit_cast(float, ww[1] & 0xffff0000u) - mean) * rstd * g0.w + b0.w;
                o1.x = (__builtin_bit_cast(float, ww[2] << 16) - mean) * rstd * g1.x + b1.x; o1.y = (__builtin_bit_cast(float, ww[2] & 0xffff0000u) - mean) * rstd * g1.y + b1.y;
                o1.z = (__builtin_bit_cast(float, ww[3] << 16) - mean) * rstd * g1.z + b1.z; o1.w = (__builtin_bit_cast(float, ww[3] & 0xffff0000u) - mean) * rstd * g1.w + b1.w;
                *(LAS f32x4*)(Vn + s * 128 + c8) = o0; *(LAS f32x4*)(Vn + s * 128 + c8 + 4) = o1; }
#pragma unroll
            for (int i = 0; i < 8; ++i) { const int e4 = tid + 512 * i; *(LAS f32x4*)(WT + e4 * 4) = *(const GAS f32x4*)(wst + (size_t)g * 16384 + e4 * 4); }
            __syncthreads();
            { int tid2 = tid; asm volatile("" : "+v"(tid2)); const int c = tid2 & 127, tq = tid2 >> 7; float acc[32];
#pragma unroll
              for (int i = 0; i < 32; ++i) acc[i] = 0.f;
              const int smax = tq * 32 + 32;
              for (int s = 0; s < smax; ++s) { const float vn = Vn[s * 128 + c];
#pragma unroll
                  for (int i4 = 0; i4 < 8; ++i4) { const f32x4 w4 = *(const LAS f32x4*)(WT + s * 128 + tq * 32 + i4 * 4);
#pragma unroll
                      for (int e = 0; e < 4; ++e) acc[i4 * 4 + e] += w4[e] * vn; } }
#pragma unroll
              for (int i = 0; i < 32; ++i) { const int t = tq * 32 + i; const size_t row = row0 + t;
                  const float uu = bf2f(z[row * GM_PROJ + g * GM_C + c]); const float yv = uu * (acc[i] + b_s[g * GM_C + t]);
                  Y[row * D + g * GM_C + c] = (bf16)f2bf(yv); } }
            __syncthreads();
        }
    }
}


__device__ __forceinline__ void gmlp_mfma_phase(const bf16* z, const float* ln_g, const float* ln_b, const bf16* wsb, const float* b_s, bf16* Y, LAS unsigned char* lds, int tid, int G) {
    asm volatile("" : "+v"(tid));
    constexpr int VSTR = 272;
    LAS float* ST = (LAS float*)(lds + XTRA_OFF);
    const int lane = tid & 63, wave = __builtin_amdgcn_readfirstlane(tid >> 6);
    const int l15 = lane & 15, lg = lane >> 4;
    for (int u = blockIdx.x; u < BATCH * (SEQ / GM_C); u += G) {
        const size_t row0 = (size_t)u * GM_C;
#pragma unroll 1
        for (int rb = 0; rb < 4; ++rb) {
            v4u raw4[4][4];
#pragma unroll
            for (int q = 0; q < 4; ++q) { const bf16* vr = z + (row0 + wave * 16 + rb * 4 + q) * GM_PROJ + 2048 + lane * 8;
#pragma unroll
                for (int jj = 0; jj < 4; ++jj) raw4[q][jj] = *(const GAS v4u*)(vr + 512 * jj); }
#pragma unroll
            for (int q = 0; q < 4; ++q) { float x[32]; float sm = 0.f;
#pragma unroll
                for (int jj = 0; jj < 4; ++jj) { const v4u w = raw4[q][jj]; const unsigned ww[4] = {w.x, w.y, w.z, w.w};
#pragma unroll
                    for (int e = 0; e < 4; ++e) { x[jj * 8 + 2 * e] = bfw(ww[e], 0); x[jj * 8 + 2 * e + 1] = bfw(ww[e], 1); sm += x[jj * 8 + 2 * e] + x[jj * 8 + 2 * e + 1]; } }
                const float mean = wave_sum(sm) * (1.f / 2048.f); float qq = 0.f;
#pragma unroll
                for (int e = 0; e < 32; ++e) { const float d = x[e] - mean; qq += d * d; }
                const float rstd = __builtin_amdgcn_rsqf(wave_sum(qq) * (1.f / 2048.f) + EPS);
                if (lane == 0) { const int r = wave * 16 + rb * 4 + q; ST[2 * r] = mean; ST[2 * r + 1] = rstd; } }
        }
        const bf16* src0 = z + (row0 + 16 * wave) * GM_PROJ + 2048 + 2 * lane;
        unsigned raw[16];
#pragma unroll
        for (int i = 0; i < 16; ++i) raw[i] = *(const GAS unsigned*)(src0 + (size_t)i * GM_PROJ);
        LBAR();
        for (int g = 0; g < GM_G; ++g) {
            LAS unsigned char* VT = lds + (g & 1) * (128 * VSTR);
            {
                const int cp = lane;
                const float g0 = ln_g[g * GM_C + 2 * cp], g1 = ln_g[g * GM_C + 2 * cp + 1], b0 = ln_b[g * GM_C + 2 * cp], b1 = ln_b[g * GM_C + 2 * cp + 1];
                unsigned lo[8], hi[8];
#pragma unroll
                for (int i = 0; i < 8; ++i) { const f32x4 st = *(const LAS f32x4*)(ST + 2 * (16 * wave + 2 * i));
                    const float x00 = (bfw(raw[2 * i], 0) - st.x) * st.y * g0 + b0, x01 = (bfw(raw[2 * i], 1) - st.x) * st.y * g1 + b1;
                    const float x10 = (bfw(raw[2 * i + 1], 0) - st.z) * st.w * g0 + b0, x11 = (bfw(raw[2 * i + 1], 1) - st.z) * st.w * g1 + b1;
                    lo[i] = pk2(x00, x10); hi[i] = pk2(x01, x11); }
                LAS unsigned char* d0 = VT + (2 * cp) * VSTR + 32 * wave;
                *(LAS v4u*)(d0) = (v4u){lo[0], lo[1], lo[2], lo[3]}; *(LAS v4u*)(d0 + 16) = (v4u){lo[4], lo[5], lo[6], lo[7]};
                *(LAS v4u*)(d0 + VSTR) = (v4u){hi[0], hi[1], hi[2], hi[3]}; *(LAS v4u*)(d0 + VSTR + 16) = (v4u){hi[4], hi[5], hi[6], hi[7]};
            }
            if (g + 1 < GM_G) {
#pragma unroll
                for (int i = 0; i < 16; ++i) raw[i] = *(const GAS unsigned*)(src0 + (g + 1) * GM_C + (size_t)i * GM_PROJ);
            }
            const int t = 16 * wave + l15; const size_t row = row0 + t;
            const bf16* up = z + row * GM_PROJ + g * GM_C + 4 * lg;
            v2u uu[8];
#pragma unroll
            for (int ct = 0; ct < 8; ++ct) uu[ct] = *(const GAS v2u*)(up + 16 * ct);
            const float bs = b_s[g * GM_C + t];
            const int nk = (wave >> 1) + 1;
            const bf16* wrow = wsb + ((size_t)g * GM_C + 16 * wave + l15) * GM_C + 8 * lg;
            bf16x8 wf[4];
#pragma unroll
            for (int ks = 0; ks < 4; ++ks) if (ks < nk) wf[ks] = *(const GAS bf16x8*)(wrow + 32 * ks);
            LBAR();
            f32x4 acc[8];
#pragma unroll
            for (int ct = 0; ct < 8; ++ct) acc[ct] = (f32x4){0.f, 0.f, 0.f, 0.f};
#pragma unroll
            for (int ks = 0; ks < 4; ++ks) if (ks < nk) {
#pragma unroll
                for (int ct = 0; ct < 8; ++ct) { const bf16x8 vf = *(const LAS bf16x8*)(VT + (16 * ct + l15) * VSTR + 64 * ks + 16 * lg);
                    acc[ct] = __builtin_amdgcn_mfma_f32_16x16x32_bf16(vf, wf[ks], acc[ct], 0, 0, 0); }
            }
            { bf16* yp = Y + row * D + g * GM_C + 4 * lg;
#pragma unroll
              for (int ct = 0; ct < 8; ++ct) { const unsigned ux = uu[ct].x, uy = uu[ct].y;
                  v2u o; o.x = pk2(bfw(ux, 0) * (acc[ct][0] + bs), bfw(ux, 1) * (acc[ct][1] + bs)); o.y = pk2(bfw(uy, 0) * (acc[ct][2] + bs), bfw(uy, 1) * (acc[ct][3] + bs));
                  *(GAS v2u*)(yp + 16 * ct) = o; } }
        }
        LBAR();
    }
}

typedef __bf16 bf16x2_t __attribute__((ext_vector_type(2)));
__device__ __forceinline__ unsigned cvtpk(float lo, float hi) { const pg8::f32x2 v = {lo, hi}; return __builtin_bit_cast(unsigned, __builtin_convertvector(v, bf16x2_t)); }
__device__ __forceinline__ void hgrn_mfma_phase(const bf16* proj, const float* lb_logits, int j, const float* out_norm, bf16* Y, LAS unsigned char* lds, int tid, int G) {
    asm volatile("" : "+v"(tid));
    constexpr int QS = 272, TS = 80, OS = 528;
    LAS unsigned char* const QT = lds;
    LAS unsigned char* const KT = lds + 8704;
    LAS unsigned char* const KHT = lds + 17408;
    LAS unsigned char* const VT = lds + 27648;
    LAS unsigned char* const AM = lds + 37888;
    LAS unsigned char* const OB = lds + 40448;
    LAS unsigned char* const GT = lds + 57344;
    LAS float* const TOT = (LAS float*)(lds + 65536);
    LAS float* const DL = (LAS float*)(lds + 69632);
    const int lane = tid & 63, wave = __builtin_amdgcn_readfirstlane(tid >> 6), l15 = lane & 15, lg = lane >> 4;
    const int t_o = tid >> 4, v8 = (tid & 15) * 8;
    for (int u = blockIdx.x; u < BATCH * HG_HEADS; u += G) {
        const int b = u / HG_HEADS, hd = u % HG_HEADS;
        float lbf[2], oml[2];
#pragma unroll
        for (int e = 0; e < 2; ++e) { const int ch = hd * HG_K + 2 * lane + e; const float l0 = lb_logits[ch], l1 = lb_logits[2048 + ch];
            const float lb = (j == 0) ? 0.f : 1.0f / (1.0f + __expf(l0 - l1)); lbf[e] = fmaxf(lb, 1e-30f); oml[e] = 1.0f - lb; }
        float onw[8];
#pragma unroll
        for (int i = 0; i < 8; ++i) onw[i] = out_norm[v8 + i];
        f32x4 S[8];
#pragma unroll
        for (int kt = 0; kt < 8; ++kt) S[kt] = (f32x4){0.f, 0.f, 0.f, 0.f};
        const bf16* base = proj + ((size_t)b * SEQ + 4 * wave) * HG_PROJ + hd * HG_K + 2 * lane;
        unsigned rq[4], rf[4], ri[4], rg[4];
#pragma unroll
        for (int i = 0; i < 4; ++i) { const bf16* p = base + (size_t)i * HG_PROJ; rq[i] = *(const GAS unsigned*)p; rf[i] = *(const GAS unsigned*)(p + 2048); ri[i] = *(const GAS unsigned*)(p + 4096); rg[i] = *(const GAS unsigned*)(p + 6144); }
        for (int t0 = 0; t0 < SEQ; t0 += 32) {
            float q[4][2], kk[4][2], cs[4][2];
#pragma unroll
            for (int i = 0; i < 4; ++i)
#pragma unroll
                for (int e = 0; e < 2; ++e) { const float zq = bfw(rq[i], e); q[i][e] = zq * __builtin_amdgcn_rcpf(1.0f + __builtin_amdgcn_exp2f(-1.4426950408889634f * zq));
                    const float zf = fmaxf(bfw(rf[i], e), -80.f); const float en = __builtin_amdgcn_exp2f(-1.4426950408889634f * zf), sg = __builtin_amdgcn_rcpf(1.0f + en);
                    const float lf = __builtin_amdgcn_logf(lbf[e] + oml[e] * sg); kk[i][e] = oml[e] * en * sg; cs[i][e] = (i == 0) ? lf : cs[i - 1][e] + lf; }
            *(LAS pg8::f32x2*)(TOT + wave * 128 + 2 * lane) = (pg8::f32x2){cs[3][0], cs[3][1]};
#pragma unroll
            for (int i = 0; i < 4; ++i) *(LAS unsigned*)(GT + (4 * wave + i) * 256 + 4 * lane) = rg[i];
            *(LAS v2u*)(VT + (2 * lane) * TS + 8 * wave) = (v2u){(ri[0] & 0xffffu) | (ri[1] << 16), (ri[2] & 0xffffu) | (ri[3] << 16)};
            *(LAS v2u*)(VT + (2 * lane + 1) * TS + 8 * wave) = (v2u){(ri[0] >> 16) | (ri[1] & 0xffff0000u), (ri[2] >> 16) | (ri[3] & 0xffff0000u)};
            if (t0 + 32 < SEQ) {
#pragma unroll
                for (int i = 0; i < 4; ++i) { const bf16* p = base + (size_t)(t0 + 32 + i) * HG_PROJ; rq[i] = *(const GAS unsigned*)p; rf[i] = *(const GAS unsigned*)(p + 2048); ri[i] = *(const GAS unsigned*)(p + 4096); rg[i] = *(const GAS unsigned*)(p + 6144); }
            }
            LBAR();
            { float pre[2] = {0.f, 0.f}, tot[2] = {0.f, 0.f};
#pragma unroll
              for (int w2 = 0; w2 < 8; ++w2) { const pg8::f32x2 tv = *(const LAS pg8::f32x2*)(TOT + w2 * 128 + 2 * lane); const float a0 = tv.x, a1 = tv.y;
                  tot[0] += a0; tot[1] += a1; if (w2 < wave) { pre[0] += a0; pre[1] += a1; } }
              float kh[4][2];
#pragma unroll
              for (int i = 0; i < 4; ++i) { float qt[2], kt2[2];
#pragma unroll
                  for (int e = 0; e < 2; ++e) { const float bb = pre[e] + cs[i][e];
                      qt[e] = q[i][e] * __builtin_amdgcn_exp2f(bb); kt2[e] = kk[i][e] * __builtin_amdgcn_exp2f(fminf(-bb, 115.f)); kh[i][e] = kk[i][e] * __builtin_amdgcn_exp2f(tot[e] - bb); }
                  *(LAS unsigned*)(QT + (4 * wave + i) * QS + 4 * lane) = cvtpk(qt[0], qt[1]);
                  *(LAS unsigned*)(KT + (4 * wave + i) * QS + 4 * lane) = cvtpk(kt2[0], kt2[1]); }
              *(LAS v2u*)(KHT + (2 * lane) * TS + 8 * wave) = (v2u){cvtpk(kh[0][0], kh[1][0]), cvtpk(kh[2][0], kh[3][0])};
              *(LAS v2u*)(KHT + (2 * lane + 1) * TS + 8 * wave) = (v2u){cvtpk(kh[0][1], kh[1][1]), cvtpk(kh[2][1], kh[3][1])};
              if (wave == 0) *(LAS pg8::f32x2*)(DL + 2 * lane) = (pg8::f32x2){__builtin_amdgcn_exp2f(tot[0]), __builtin_amdgcn_exp2f(tot[1])}; }
            LBAR();
            if (wave < 3) { const int tt = wave ? 1 : 0, st = (wave == 2) ? 1 : 0; f32x4 am = (f32x4){0.f, 0.f, 0.f, 0.f};
#pragma unroll
                for (int k4 = 0; k4 < 4; ++k4) { const bf16x8 a = *(const LAS bf16x8*)(QT + (16 * tt + l15) * QS + 64 * k4 + 16 * lg); const bf16x8 bq = *(const LAS bf16x8*)(KT + (16 * st + l15) * QS + 64 * k4 + 16 * lg);
                    am = __builtin_amdgcn_mfma_f32_16x16x32_bf16(a, bq, am, 0, 0, 0); }
#pragma unroll
                for (int r = 0; r < 4; ++r) { const int tl = 4 * lg + r; const float val = (tt != st || l15 <= tl) ? am[r] : 0.f;
                    *(LAS unsigned short*)(AM + (16 * tt + tl) * TS + (16 * st + l15) * 2) = (unsigned short)f2bf(val); } }
            else if (wave == 3) {
#pragma unroll
                for (int r = 0; r < 4; ++r) *(LAS unsigned short*)(AM + (4 * lg + r) * TS + (16 + l15) * 2) = (unsigned short)0; }
            f32x4 o[2] = {(f32x4){0.f, 0.f, 0.f, 0.f}, (f32x4){0.f, 0.f, 0.f, 0.f}};
#pragma unroll
            for (int k2 = 0; k2 < 4; ++k2) {
                const v4u sb = (v4u){cvtpk(S[2 * k2][0], S[2 * k2][1]), cvtpk(S[2 * k2][2], S[2 * k2][3]), cvtpk(S[2 * k2 + 1][0], S[2 * k2 + 1][1]), cvtpk(S[2 * k2 + 1][2], S[2 * k2 + 1][3])};
                const bf16x8 sfrag = __builtin_bit_cast(bf16x8, sb);
#pragma unroll
                for (int tt = 0; tt < 2; ++tt) { const LAS unsigned char* qp = QT + (16 * tt + l15) * QS + (32 * k2 + 4 * lg) * 2;
                    const v2u lo = *(const LAS v2u*)qp, hi = *(const LAS v2u*)(qp + 32);
                    const bf16x8 a = __builtin_bit_cast(bf16x8, (v4u){lo.x, lo.y, hi.x, hi.y});
                    o[tt] = __builtin_amdgcn_mfma_f32_16x16x32_bf16(a, sfrag, o[tt], 0, 0, 0); }
            }
            LBAR();
            { const bf16x8 vfrag = *(const LAS bf16x8*)(VT + (16 * wave + l15) * TS + 16 * lg);
#pragma unroll
              for (int tt = 0; tt < 2; ++tt) { const bf16x8 a = *(const LAS bf16x8*)(AM + (16 * tt + l15) * TS + 16 * lg); o[tt] = __builtin_amdgcn_mfma_f32_16x16x32_bf16(a, vfrag, o[tt], 0, 0, 0);
#pragma unroll
                  for (int r = 0; r < 4; ++r) *(LAS float*)(OB + (16 * tt + 4 * lg + r) * OS + (16 * wave + l15) * 4) = o[tt][r]; }
#pragma unroll
              for (int kt = 0; kt < 8; ++kt) { const f32x4 d4 = *(const LAS f32x4*)(DL + 16 * kt + 4 * lg); const bf16x8 a = *(const LAS bf16x8*)(KHT + (16 * kt + l15) * TS + 16 * lg);
                  S[kt] = __builtin_amdgcn_mfma_f32_16x16x32_bf16(a, vfrag, S[kt] * d4, 0, 0, 0); } }
            LBAR();
            { const f32x4 o0 = *(const LAS f32x4*)(OB + t_o * OS + v8 * 4), o1 = *(const LAS f32x4*)(OB + t_o * OS + v8 * 4 + 16);
              float ss = dot4(o0) + dot4(o1);
#pragma unroll
              for (int m = 1; m < 16; m <<= 1) ss += __shfl_xor(ss, m);
              const float rstd = __builtin_amdgcn_rsqf(ss * (1.f / 128.f) + EPS);
              const v4u gr = *(const LAS v4u*)(GT + t_o * 256 + v8 * 2); const unsigned gw4[4] = {gr.x, gr.y, gr.z, gr.w};
              float y[8];
#pragma unroll
              for (int i = 0; i < 8; ++i) { const float gv = bfw(gw4[i >> 1], i & 1); const float ov = (i < 4) ? o0[i & 3] : o1[i & 3]; y[i] = ov * rstd * onw[i] * (gv * __builtin_amdgcn_rcpf(1.0f + __builtin_amdgcn_exp2f(-1.4426950408889634f * gv))); }
              if (HG_FILTER(t0, t_o)) *(GAS v4u*)(Y + ((size_t)b * SEQ + t0 + t_o) * D + hd * HG_K + v8) = (v4u){pk2(y[0], y[1]), pk2(y[2], y[3]), pk2(y[4], y[5]), pk2(y[6], y[7])}; }
            LBAR();
        }
    }
}

struct Args { In in; float* out; unsigned char* ws; int ph_lo, ph_hi; };
__global__ void __launch_bounds__(NWAVES * 64, 2) fwd(Args args) {
    extern __shared__ __attribute__((aligned(16))) unsigned char lds_raw[];
    LAS unsigned char* lds = (LAS unsigned char*)lds_raw;
    volatile LAS unsigned* MISC = (volatile LAS unsigned*)(lds + MISC_OFF);
    const int tid = threadIdx.x, lane = tid & 63, wave = __builtin_amdgcn_readfirstlane(tid >> 6);
    const int G = gridDim.x; const int bx = blockIdx.x; const int vcu = (G % 8 == 0) ? (bx % 8) * (G / 8) + bx / 8 : bx;
    const int gw = vcu * NWAVES + wave, NGW = G * NWAVES;
    unsigned char* ws = args.ws; gu32* ctl = (gu32*)(ws + WS_CTL);
    for (int u = tid; u < (LDS_BYTES - LDSCTL_OFF) / 4; u += NWAVES * 64) ((LAS unsigned*)(lds + LDSCTL_OFF))[u] = 0u;
    __syncthreads();
    XcdBarrier bar; bar.bar = (unsigned*)(ctl + CW_BAR); bar.x = 0; bar.st = nullptr;
    if (MK_ONE_LAUNCH) bar = xcd_barrier_post((unsigned*)(ctl + CW_BAR), MISC + 8);
    const int lo = args.ph_lo, hi = args.ph_hi;
#define IN(k) (lo <= (k) && (k) < hi)
#define SEAM(k) do { if (IN(k) && IN((k) + 1)) { xcd_barrier(bar); if (DUP(12)) xcd_barrier(bar); } } while (0)
    const In& in = args.in;
    bf16* const A = (bf16*)(ws + WS_A); bf16* const BIG = (bf16*)(ws + WS_BIG); bf16* const MO = (bf16*)(ws + WS_MO); bf16* const H16 = (bf16*)(ws + WS_MO + 128 * MiB); float* const RS = (float*)(ws + WS_RS);
    float* const out = args.out;

    if (!DIS_THIN && IN(0)) { convert_layer(in, ws, 0, lds, gw, NGW, wave, lane); rows_to_bf16_rs(in.p[0], H16, RS, gw, NGW, lane); }
    SEAM(0);

    for (int L = 0; L < NLOOP; ++L) {
        const int pb = 1 + 9 * L, j = L >> 1;
        if (L & 1) {
            if (EN(0) && IN(pb)) { pg8::Gemm g{H16, (const bf16*)(ws + WS_W1), M, GM_PROJ, D}; pg8::StaticOrder S; S.init(M, GM_PROJ, G, bx);
                pg8::EpiBf16<1, true> E{BIG, GM_PROJ, NT_G1G, RS}; pg8::gemm_phase<pg8::EpiBf16<1, true>, pg8::StaticOrder, PG_ALIGN, PG_SP2>(lds + RING_OFF, g, S, E); if (DUP(0)) { __syncthreads(); pg8::gemm_phase<pg8::EpiBf16<1, true>, pg8::StaticOrder, PG_ALIGN, PG_SP2>(lds + RING_OFF, g, S, E); } }
            SEAM(pb);
            if (!DIS_GMLP && IN(pb + 1)) {
#if GMLP_NAIVE
                gmlp_naive_phase(BIG, in.p[7] + j * 2048, in.p[8] + j * 2048, (const float*)(ws + WS_WST), in.p[10] + j * GM_G * GM_C, A, lds, tid, G);
                if (DUP(6)) gmlp_naive_phase(BIG, in.p[7] + j * 2048, in.p[8] + j * 2048, (const float*)(ws + WS_WST), in.p[10] + j * GM_G * GM_C, A, lds, tid, G);
#else
                gmlp_mfma_phase(BIG, in.p[7] + j * 2048, in.p[8] + j * 2048, (const bf16*)(ws + WS_WSB), in.p[10] + j * GM_G * GM_C, A, lds, tid, G);
                if (DUP(6)) gmlp_mfma_phase(BIG, in.p[7] + j * 2048, in.p[8] + j * 2048, (const bf16*)(ws + WS_WSB), in.p[10] + j * GM_G * GM_C, A, lds, tid, G);
#endif
            }
            SEAM(pb + 1);
        } else {
            if (EN(1) && IN(pb)) { pg8::Gemm g{H16, (const bf16*)(ws + WS_W1), M, HG_PROJ, D}; pg8::StaticOrder S; S.init(M, HG_PROJ, G, bx);
                pg8::EpiBf16<0, true> E{BIG, HG_PROJ, NT_G1H, RS}; pg8::gemm_phase<pg8::EpiBf16<0, true>, pg8::StaticOrder, PG_ALIGN, PG_SP2>(lds + RING_OFF, g, S, E); if (DUP(1)) { __syncthreads(); pg8::gemm_phase<pg8::EpiBf16<0, true>, pg8::StaticOrder, PG_ALIGN, PG_SP2>(lds + RING_OFF, g, S, E); } }
            SEAM(pb);
            if (!DIS_HGRN && IN(pb + 1)) {
#if HGRN_NAIVE
                hgrn_naive_phase(BIG, in.p[3], j, in.p[4] + j * HG_K, A, lds, tid, G);
                if (DUP(7)) hgrn_naive_phase(BIG, in.p[3], j, in.p[4] + j * HG_K, A, lds, tid, G);
#else
                if (HG_BOTH) { hgrn_naive_phase(BIG, in.p[3], j, in.p[4] + j * HG_K, A, lds, tid, G); __syncthreads(); }
                hgrn_mfma_phase(BIG, in.p[3], j, in.p[4] + j * HG_K, A, lds, tid, G);
                if (DUP(7)) hgrn_mfma_phase(BIG, in.p[3], j, in.p[4] + j * HG_K, A, lds, tid, G);
#endif
            }
            SEAM(pb + 1);
        }
        if (EN(2) && IN(pb + 2)) { pg8::Gemm g{A, (const bf16*)(ws + WS_W2), M, D, D}; pg8::StaticOrder S; S.init(M, D, G, bx);
            pg8::EpiBf16<0> E{MO, D, 0, nullptr}; pg8::gemm_phase<pg8::EpiBf16<0>, pg8::StaticOrder, PG_ALIGN, PG_SP2>(lds + RING_OFF, g, S, E); if (DUP(2)) { __syncthreads(); pg8::gemm_phase<pg8::EpiBf16<0>, pg8::StaticOrder, PG_ALIGN, PG_SP2>(lds + RING_OFF, g, S, E); } }
        SEAM(pb + 2);
        if (!DIS_THIN && IN(pb + 3)) { if (L == 0) thin_phase<true, false, true>(in.p[0], MO, in.p[13] + L * D, nullptr, H16, RS, gw, NGW, lane);
            else thin_phase<false, false, true>(H16, MO, in.p[13] + L * D, nullptr, H16, RS, gw, NGW, lane); }
        SEAM(pb + 3);
        if (EN(3) && IN(pb + 4)) { pg8::Gemm g{H16, (const bf16*)(ws + WS_WGU), M, 2 * FF, D}; pg8::StaticOrder S; S.init(M, 2 * FF, G, bx);
            pg8::EpiSwiGLU E{BIG, FF, RS}; pg8::gemm_phase<pg8::EpiSwiGLU, pg8::StaticOrder, PG_ALIGN, PG_SP2>(lds + RING_OFF, g, S, E); if (DUP(10)) { __syncthreads(); pg8::gemm_phase<pg8::EpiSwiGLU, pg8::StaticOrder, PG_ALIGN, PG_SP2, true>(lds + RING_OFF, g, S, E); } if (DUP(3)) { __syncthreads(); pg8::gemm_phase<pg8::EpiSwiGLU, pg8::StaticOrder, PG_ALIGN, PG_SP2>(lds + RING_OFF, g, S, E); } }
        SEAM(pb + 4);
        if (EN(4) && IN(pb + 5)) { pg8::Gemm g{BIG, (const bf16*)(ws + WS_WD), M, D, FF}; pg8::StaticOrder S; S.init(M, D, G, bx);
            pg8::EpiBf16<0> E{MO, D, 0, nullptr}; pg8::gemm_phase<pg8::EpiBf16<0>, pg8::StaticOrder, PG_ALIGN, PG_SP2>(lds + RING_OFF, g, S, E); if (DUP(4)) { __syncthreads(); pg8::gemm_phase<pg8::EpiBf16<0>, pg8::StaticOrder, PG_ALIGN, PG_SP2>(lds + RING_OFF, g, S, E); } }
        SEAM(pb + 5);
        if (!DIS_THIN && IN(pb + 6)) thin_phase<false, false, false>(H16, MO, in.p[15] + L * D, nullptr, H16, nullptr, gw, NGW, lane);
        SEAM(pb + 6);
        if (IN(pb + 7)) {
            if (EN(5)) { pg8::Gemm g{(const bf16*)(ws + WS_PB), (const bf16*)(ws + WS_WPP), M, D, PLE}; pg8::StaticOrder S; S.init(M, D, G, bx);
              pg8::EpiBf16<0> E{MO, D, 0, nullptr}; pg8::gemm_phase<pg8::EpiBf16<0>, pg8::StaticOrder, PG_ALIGN, PG_SP2>(lds + RING_OFF, g, S, E); }
            __syncthreads();
            if (EN(6)) { pg8::Gemm g{H16, (const bf16*)(ws + WS_WPG), M, D, D}; pg8::StaticOrder S; S.init(M, D, G, bx);
              pg8::EpiGateMulBf16 E{MO, D}; pg8::gemm_phase<pg8::EpiGateMulBf16, pg8::StaticOrder, PG_ALIGN, PG_SP2>(lds + RING_OFF, g, S, E); }
            if (DUP(5)) { __syncthreads();
            if (EN(5)) { pg8::Gemm g{(const bf16*)(ws + WS_PB), (const bf16*)(ws + WS_WPP), M, D, PLE}; pg8::StaticOrder S; S.init(M, D, G, bx);
              pg8::EpiBf16<0> E{MO, D, 0, nullptr}; pg8::gemm_phase<pg8::EpiBf16<0>, pg8::StaticOrder, PG_ALIGN, PG_SP2>(lds + RING_OFF, g, S, E); }
            __syncthreads();
            if (EN(6)) { pg8::Gemm g{H16, (const bf16*)(ws + WS_WPG), M, D, D}; pg8::StaticOrder S; S.init(M, D, G, bx);
              pg8::EpiGateMulBf16 E{MO, D}; pg8::gemm_phase<pg8::EpiGateMulBf16, pg8::StaticOrder, PG_ALIGN, PG_SP2>(lds + RING_OFF, g, S, E); }
            }
        }
        SEAM(pb + 7);
        if (!DIS_THIN && IN(pb + 8)) {
            if (L + 1 < DEPTH) { thin_phase<false, false, true>(H16, MO, in.p[21] + L * D, nullptr, H16, RS, gw, NGW, lane); __syncthreads(); convert_layer(in, ws, L + 1, lds, gw, NGW, wave, lane); if (DUP(9)) { __syncthreads(); convert_layer(in, ws, L + 1, lds, gw, NGW, wave, lane); } }
            else thin_phase<false, true, false>(H16, MO, in.p[21] + L * D, nullptr, out, nullptr, gw, NGW, lane);
        }
        SEAM(pb + 8);
    }
#undef IN
#undef SEAM
}

extern "C" void kernel_launch(void* const* d_in, const int* in_sizes, int n_in, void* d_out, int out_size, void* d_ws, size_t ws_size, hipStream_t stream) {
    static int grid = 0;
    if (grid == 0) {
        if (n_in != 22 || out_size != M * D || ws_size < WS_END) { fprintf(stderr, "kernel_launch: unexpected shapes: n_in %d out %d ws %zu (need %zu)\n", n_in, out_size, ws_size, (size_t)WS_END); grid = -1; return; }
        int dev = 0, cus = 0, per_cu = 0;
        if (hipGetDevice(&dev) != hipSuccess || hipDeviceGetAttribute(&cus, hipDeviceAttributeMultiprocessorCount, dev) != hipSuccess) { grid = -1; return; }
        if (hipFuncSetAttribute((const void*)fwd, hipFuncAttributeMaxDynamicSharedMemorySize, LDS_BYTES) != hipSuccess) { fprintf(stderr, "kernel_launch: hipFuncSetAttribute failed\n"); grid = -1; return; }
        if (hipOccupancyMaxActiveBlocksPerMultiprocessor(&per_cu, (const void*)fwd, NWAVES * 64, LDS_BYTES) != hipSuccess || per_cu < 1) fprintf(stderr, "kernel_launch: occupancy query says %d\n", per_cu);
        (void)hipGetLastError();
        grid = cus;
    }
    if (grid < 0) return;
    (void)hipMemsetAsync((char*)d_ws + WS_CTL, 0, CTL_ZERO_BYTES, stream);
    Args a{};
    for (int i = 0; i < 22; ++i) a.in.p[i] = (const float*)d_in[i];
    a.out = (float*)d_out; a.ws = (unsigned char*)d_ws;
#if MK_ONE_LAUNCH
    a.ph_lo = 0; a.ph_hi = NPHASE;
    hipLaunchKernelGGL(fwd, dim3(grid), dim3(NWAVES * 64), LDS_BYTES, stream, a);
#else
    for (int p = 0; p < NPHASE; ++p) { a.ph_lo = p; a.ph_hi = p + 1; hipLaunchKernelGGL(fwd, dim3(grid), dim3(NWAVES * 64), LDS_BYTES, stream, a); }
#endif
}
```

```cpp
#include <hip/hip_runtime.h>
#include <cstdio>
#include <cstdint>
#ifndef PG_WGM
#define PG_WGM 4
#endif
namespace pg8 {
#define PG8_LAS __attribute__((address_space(3)))
typedef unsigned short bf16_t;
typedef short bf16x8 __attribute__((ext_vector_type(8)));
typedef float f32x4 __attribute__((ext_vector_type(4)));
typedef unsigned u32x4 __attribute__((ext_vector_type(4)));
constexpr int BM = 256, BK = 64, HALF = 128, HTB = HALF * BK * 2  , STAGE_BYTES = 8 * HTB, NXCD = 8, WGM = PG_WGM;

__host__ __device__ __forceinline__ int lds_byte(int r, int c) { const int st = (r >> 4) * 2 + (c >> 5), rr = r & 15, cc = c & 31, ob = rr * 64 + cc * 2; return st * 1024 + (ob ^ (((ob >> 9) & 1) << 5)); }
__host__ __device__ __forceinline__ void stage_rc(int b, int& R, int& C) { const int st = b / 1024, sb = b % 1024, swz = sb ^ (((sb >> 9) & 1) << 5); R = (st >> 1) * 16 + swz / 64; C = (st & 1) * 32 + (swz % 64) / 2; }
__host__ __device__ __forceinline__ int perm32(int rho) { const int n = rho >> 4, i = rho & 15; return 8 * (i >> 2) + 4 * n + (i & 3); }

struct Unit { int pm, pn; };
struct Gemm { const bf16_t* A; const bf16_t* Bt; int M, N, K; };

struct StaticOrder {
    int nM, nN, nwg, G, c;
    __host__ __device__ void init(int M, int N, int G_, int c_) { nM = M / BM; nN = N / BM; nwg = nM * nN; G = G_; c = c_; }
    __host__ __device__ bool next(int i, Unit& u) const {
        const long L = (long)i * G + c; if (L >= nwg) return false;
        int wgid = (int)L; { const int q = nwg / NXCD, r = nwg % NXCD, xcd = wgid % NXCD, off = wgid / NXCD; wgid = (xcd < r ? xcd * (q + 1) : r * (q + 1) + (xcd - r) * q) + off; }
        const int nig = WGM * nN, gid = wgid / nig, fm = gid * WGM, gsz = (nM - fm) < WGM ? (nM - fm) : WGM;
        u.pm = fm + ((wgid % nig) % gsz); u.pn = (wgid % nig) / gsz; return true;
    }
    __device__ __forceinline__ void a_ready(const Unit&) const {}
    __device__ __forceinline__ void done(const Unit&) const {}
};


__device__ __forceinline__ unsigned cvt_pk_bf16(float lo, float hi) { unsigned r; asm volatile("v_cvt_pk_bf16_f32 %0, %1, %2" : "=v"(r) : "v"(lo), "v"(hi)); return r; }
typedef float f32x2 __attribute__((ext_vector_type(2)));
#ifndef NT_STORE
#define NT_STORE 0
#endif
__device__ __forceinline__ f32x2 gelu_pk(f32x2 v) {
    const f32x2 av = __builtin_elementwise_abs(v), d = av * 0.2316418882f + 1.0f;
    f32x2 t; t.x = __builtin_amdgcn_rcpf(d.x); t.y = __builtin_amdgcn_rcpf(d.y);
    f32x2 q = t * 0.5307027145f + (-0.7265760135f); q = q * t + 0.7107068705f; q = q * t + (-0.142248368f); q = q * t + 0.127414796f; q = q * t;
    const f32x2 s = (v * v) * (-0.72134752044f);
    f32x2 e; e.x = __builtin_amdgcn_exp2f(s.x); e.y = __builtin_amdgcn_exp2f(s.y);
    const f32x2 m = v * (q * e), r = v - m;
    f32x2 o; o.x = v.x < 0.f ? m.x : r.x; o.y = v.y < 0.f ? m.y : r.y; return o;
}
__device__ __forceinline__ float sigmoid_f(float x) { return __builtin_amdgcn_rcpf(1.0f + __builtin_amdgcn_exp2f(-1.4426950408889634f * x)); }
__device__ __forceinline__ float silu_f(float x) { return x * sigmoid_f(x); }

__host__ __device__ __forceinline__ int rs_slot(int row) { const int pm = row >> 8, r = row & 255; return (((pm * 2 + ((r >> 6) & 1)) * 16 + (r & 15)) * 8) + ((r >> 7) * 4) + ((r >> 4) & 3); }
__device__ __forceinline__ float rs_get(const u32x4& w, int i) { const unsigned x = (i >> 1) == 0 ? w.x : (i >> 1) == 1 ? w.y : (i >> 1) == 2 ? w.z : w.w; const unsigned short h = (unsigned short)((i & 1) ? (x >> 16) : (x & 0xffffu)); return (float)__builtin_bit_cast(_Float16, h); }
struct EpiF32 {
    static constexpr bool PERM = false, AFTER_DRAIN = false, ROWSCALE = false;
    float* C; int ldc;
    __device__ __forceinline__ void operator()(const f32x4 (&acc)[2][2][4][2], const Unit& u, int wr, int wc, int fr, int fq) const {
        const int row0 = u.pm * BM + wr * 64 + fr, col0 = u.pn * BM + wc * 32 + 4 * fq;
#pragma unroll
        for (int ai = 0; ai < 2; ++ai)
#pragma unroll
            for (int m = 0; m < 4; ++m) { float* rowp = C + (size_t)(row0 + ai * HALF + m * 16) * ldc + col0;
#pragma unroll
                for (int bj = 0; bj < 2; ++bj)
#pragma unroll
                    for (int n = 0; n < 2; ++n) *(f32x4*)(rowp + bj * HALF + n * 16) = acc[ai][bj][m][n]; }
    }
};
struct EpiGateMul {
    static constexpr bool PERM = false, AFTER_DRAIN = false, ROWSCALE = false;
    float* C; int ldc;
    __device__ __forceinline__ void operator()(const f32x4 (&acc)[2][2][4][2], const Unit& u, int wr, int wc, int fr, int fq) const {
        const int row0 = u.pm * BM + wr * 64 + fr, col0 = u.pn * BM + wc * 32 + 4 * fq;
#pragma unroll
        for (int ai = 0; ai < 2; ++ai)
#pragma unroll
            for (int m = 0; m < 4; ++m) { float* rowp = C + (size_t)(row0 + ai * HALF + m * 16) * ldc + col0;
#pragma unroll
                for (int bj = 0; bj < 2; ++bj)
#pragma unroll
                    for (int n = 0; n < 2; ++n) { f32x4 e = *(const f32x4*)(rowp + bj * HALF + n * 16); const f32x4 a = acc[ai][bj][m][n];
                        e[0] *= sigmoid_f(a[0]); e[1] *= sigmoid_f(a[1]); e[2] *= sigmoid_f(a[2]); e[3] *= sigmoid_f(a[3]);
                        *(f32x4*)(rowp + bj * HALF + n * 16) = e; } }
    }
};
template <int ACT, bool RS = false> struct EpiBf16 {
    static constexpr bool PERM = true, AFTER_DRAIN = false, ROWSCALE = RS;
    bf16_t* O; int ldc; int nt; const float* rs;
    __device__ __forceinline__ void prefetch(u32x4& rsv, const Unit& u, int wr, int fr) const { rsv = *(const u32x4*)((const unsigned short*)rs + ((u.pm * 2 + wr) * 16 + fr) * 8); }
    __device__ __forceinline__ void operator()(const f32x4 (&acc)[2][2][4][2], const Unit& u, int wr, int wc, int fr, int fq) const { const u32x4 one = {0x3c003c00u, 0x3c003c00u, 0x3c003c00u, 0x3c003c00u}; (*this)(acc, u, wr, wc, fr, fq, one); }
    __device__ __forceinline__ void operator()(const f32x4 (&acc)[2][2][4][2], const Unit& u, int wr, int wc, int fr, int fq, const u32x4& rsv) const {
        const int row0 = u.pm * BM + wr * 64 + fr, col0 = u.pn * BM + wc * 32 + 8 * fq;
#pragma unroll
        for (int ai = 0; ai < 2; ++ai)
#pragma unroll
            for (int m = 0; m < 4; ++m) { bf16_t* rowp = O + (size_t)(row0 + ai * HALF + m * 16) * ldc + col0; const float sc = rs_get(rsv, ai * 4 + m);
#pragma unroll
                for (int bj = 0; bj < 2; ++bj) { f32x4 v0 = acc[ai][bj][m][0], v1 = acc[ai][bj][m][1];
                    if (RS) { v0 = v0 * sc; v1 = v1 * sc; }
                    if (ACT == 1) { f32x2 a = gelu_pk((f32x2){v0[0], v0[1]}), b = gelu_pk((f32x2){v0[2], v0[3]}), c = gelu_pk((f32x2){v1[0], v1[1]}), d = gelu_pk((f32x2){v1[2], v1[3]});
                        v0 = (f32x4){a.x, a.y, b.x, b.y}; v1 = (f32x4){c.x, c.y, d.x, d.y}; }
                    u32x4 w; w.x = cvt_pk_bf16(v0[0], v0[1]); w.y = cvt_pk_bf16(v0[2], v0[3]); w.z = cvt_pk_bf16(v1[0], v1[1]); w.w = cvt_pk_bf16(v1[2], v1[3]);
                    if (nt) __builtin_nontemporal_store(w, (u32x4*)(rowp + bj * HALF)); else *(u32x4*)(rowp + bj * HALF) = w; } }
    }
};

struct EpiGateMulBf16 {
    static constexpr bool PERM = true, AFTER_DRAIN = false, ROWSCALE = false;
    bf16_t* O; int ldc;
    __device__ __forceinline__ void operator()(const f32x4 (&acc)[2][2][4][2], const Unit& u, int wr, int wc, int fr, int fq) const {
        const int row0 = u.pm * BM + wr * 64 + fr, col0 = u.pn * BM + wc * 32 + 8 * fq;
#pragma unroll
        for (int ai = 0; ai < 2; ++ai)
#pragma unroll
            for (int m = 0; m < 4; ++m) { bf16_t* rowp = O + (size_t)(row0 + ai * HALF + m * 16) * ldc + col0;
#pragma unroll
                for (int bj = 0; bj < 2; ++bj) { const u32x4 ev = *(const u32x4*)(rowp + bj * HALF); const f32x4 v0 = acc[ai][bj][m][0], v1 = acc[ai][bj][m][1];
                    const unsigned e0 = ev.x, e1 = ev.y, e2 = ev.z, e3 = ev.w;
                    u32x4 w;
                    w.x = cvt_pk_bf16(__builtin_bit_cast(float, e0 << 16) * sigmoid_f(v0[0]), __builtin_bit_cast(float, e0 & 0xffff0000u) * sigmoid_f(v0[1]));
                    w.y = cvt_pk_bf16(__builtin_bit_cast(float, e1 << 16) * sigmoid_f(v0[2]), __builtin_bit_cast(float, e1 & 0xffff0000u) * sigmoid_f(v0[3]));
                    w.z = cvt_pk_bf16(__builtin_bit_cast(float, e2 << 16) * sigmoid_f(v1[0]), __builtin_bit_cast(float, e2 & 0xffff0000u) * sigmoid_f(v1[1]));
                    w.w = cvt_pk_bf16(__builtin_bit_cast(float, e3 << 16) * sigmoid_f(v1[2]), __builtin_bit_cast(float, e3 & 0xffff0000u) * sigmoid_f(v1[3]));
                    *(u32x4*)(rowp + bj * HALF) = w; } }
    }
};
struct EpiSwiGLU {
    static constexpr bool PERM = true, AFTER_DRAIN = false, ROWSCALE = true;
    bf16_t* O; int ldc; const float* rs;
    __device__ __forceinline__ void prefetch(u32x4& rsv, const Unit& u, int wr, int fr) const { rsv = *(const u32x4*)((const unsigned short*)rs + ((u.pm * 2 + wr) * 16 + fr) * 8); }
    __device__ __forceinline__ void operator()(const f32x4 (&acc)[2][2][4][2], const Unit& u, int wr, int wc, int fr, int fq, const u32x4& rsv) const {
        const int row0 = u.pm * BM + wr * 64 + fr, col0 = u.pn * HALF + wc * 32 + 8 * fq;
#pragma unroll
        for (int ai = 0; ai < 2; ++ai)
#pragma unroll
            for (int m = 0; m < 4; ++m) { bf16_t* rowp = O + (size_t)(row0 + ai * HALF + m * 16) * ldc + col0; const float sc = rs_get(rsv, ai * 4 + m);
                const f32x4 g0 = acc[ai][0][m][0] * sc, g1 = acc[ai][0][m][1] * sc, u0 = acc[ai][1][m][0] * sc, u1 = acc[ai][1][m][1] * sc;
                u32x4 w; w.x = cvt_pk_bf16(silu_f(g0[0]) * u0[0], silu_f(g0[1]) * u0[1]); w.y = cvt_pk_bf16(silu_f(g0[2]) * u0[2], silu_f(g0[3]) * u0[3]);
                w.z = cvt_pk_bf16(silu_f(g1[0]) * u1[0], silu_f(g1[1]) * u1[1]); w.w = cvt_pk_bf16(silu_f(g1[2]) * u1[2], silu_f(g1[3]) * u1[3]);
                *(u32x4*)rowp = w; }
    }
};

template <class Epi, class Sched, bool ALIGN_EPI = false, bool SP2 = false, bool NOEPI = false>
__device__ __forceinline__ void gemm_phase(PG8_LAS unsigned char* lds, const Gemm g, const Sched& S, const Epi& E) {
    int tid_ = threadIdx.x; asm volatile("" : "+v"(tid_));
    const int tid = tid_, wid = __builtin_amdgcn_readfirstlane(tid >> 6), lane = tid & 63, wr = wid >> 2, wc = wid & 3, fr = lane & 15, fq = lane >> 4;
    const int K = g.K, nt = K / BK;
    unsigned voffA[2], voffB[2];
#pragma unroll
    for (int i = 0; i < 2; ++i) { int R, C; stage_rc(tid * 16 + i * 8192, R, C); const int Rb = Epi::PERM ? ((R & ~31) + perm32(R & 31)) : R;
        voffA[i] = (unsigned)(R * K + C) * 2u; voffB[i] = (unsigned)(Rb * K + C) * 2u; }
    const size_t kstep = (size_t)(BK * 2);
    const size_t hstep = (size_t)HALF * K * 2;
    const size_t tstep = 2 * hstep;
    const unsigned ldsw = (unsigned)wid * 1024u;
    const int aoff = lds_byte(wr * 64 + fr, fq * 8), boff = lds_byte(wc * 32 + fr, fq * 8);
#define PG8_SA(b, h) (((b) * 2 + (h)) * HTB)
#define PG8_SB(b, h) ((4 + (b) * 2 + (h)) * HTB)
#define PG8_STAGE(bufoff, gbase, voff) do { _Pragma("unroll") for (int _i = 0; _i < 2; ++_i) \
        __builtin_amdgcn_global_load_lds((const unsigned*)((const char*)(gbase) + (voff)[_i]), (PG8_LAS unsigned*)(lds + (bufoff) + ldsw + _i * 8192), 16, 0, 0); } while (0)
#define PG8_LDA(dst, b, h) do { _Pragma("unroll") for (int m = 0; m < 4; ++m) _Pragma("unroll") for (int k = 0; k < 2; ++k) dst[m][k] = *(const PG8_LAS bf16x8*)(lds + PG8_SA(b, h) + aoff + m * 2048 + k * 1024); } while (0)
#define PG8_LDB(dst, b, h) do { _Pragma("unroll") for (int n = 0; n < 2; ++n) _Pragma("unroll") for (int k = 0; k < 2; ++k) dst[n][k] = *(const PG8_LAS bf16x8*)(lds + PG8_SB(b, h) + boff + n * 2048 + k * 1024); } while (0)
#define PG8_MMA(ai, bj, At, Bt) do { __builtin_amdgcn_s_setprio(1); _Pragma("unroll") for (int m = 0; m < 4; ++m) _Pragma("unroll") for (int n = 0; n < 2; ++n) _Pragma("unroll") for (int k = 0; k < 2; ++k) \
        acc[ai][bj][m][n] = __builtin_amdgcn_mfma_f32_16x16x32_bf16(Bt[n][k], At[m][k], acc[ai][bj][m][n], 0, 0, 0); __builtin_amdgcn_s_setprio(0); } while (0)
#define PG8_WAIT_V(n) asm volatile("s_waitcnt vmcnt(" #n ")" ::: "memory")
#define PG8_WAIT_L(n) asm volatile("s_waitcnt lgkmcnt(" #n ")" ::: "memory")
#define PG8_BAR __builtin_amdgcn_s_barrier()
#define PG8_SCHED __builtin_amdgcn_sched_barrier(0)
    Unit cur, nxt; int ui = 0;
    if (!S.next(0, cur)) return;
    f32x4 acc[2][2][4][2];
#pragma unroll
    for (int a = 0; a < 2; ++a)
#pragma unroll
        for (int b = 0; b < 2; ++b)
#pragma unroll
            for (int m = 0; m < 4; ++m)
#pragma unroll
                for (int n = 0; n < 2; ++n) acc[a][b][m][n] = (f32x4){0.f, 0.f, 0.f, 0.f};
    bf16x8 At[4][2], B0[2][2], B1[2][2];
    u32x4 rsv;
    const char* cA = (const char*)g.A + (size_t)cur.pm * tstep; const char* cB = (const char*)g.Bt + (size_t)cur.pn * tstep;
    S.a_ready(cur);
    if constexpr (SP2) {
        PG8_STAGE(PG8_SB(0, 0), cB, voffB); PG8_STAGE(PG8_SB(0, 1), cB + hstep, voffB); PG8_STAGE(PG8_SA(0, 0), cA, voffA); PG8_STAGE(PG8_SA(0, 1), cA + hstep, voffA);
        if (wr == 1) PG8_BAR;
        PG8_WAIT_V(2); PG8_BAR;
        PG8_STAGE(PG8_SB(1, 0), cB + kstep, voffB); PG8_STAGE(PG8_SA(1, 0), cA + kstep, voffA); PG8_STAGE(PG8_SB(1, 1), cB + hstep + kstep, voffB);
        PG8_WAIT_V(6); PG8_BAR;
    } else {
        PG8_STAGE(PG8_SB(0, 0), cB, voffB); PG8_STAGE(PG8_SA(0, 0), cA, voffA); PG8_STAGE(PG8_SB(0, 1), cB + hstep, voffB); PG8_STAGE(PG8_SA(0, 1), cA + hstep, voffA);
        if (wr == 1) PG8_BAR;
        PG8_WAIT_V(4); PG8_BAR;
        PG8_STAGE(PG8_SB(1, 0), cB + kstep, voffB); PG8_STAGE(PG8_SA(1, 0), cA + kstep, voffA); PG8_STAGE(PG8_SB(1, 1), cB + hstep + kstep, voffB);
        PG8_WAIT_V(6); PG8_BAR;
    }
    for (;;) {
        const bool has_next = S.next(ui + 1, nxt);
        const char* nA = has_next ? (const char*)g.A + (size_t)nxt.pm * tstep : cA; const char* nB = has_next ? (const char*)g.Bt + (size_t)nxt.pn * tstep : cB;
        for (int t = 0; t < nt; t += 2) {
            const bool last = (t == nt - 2);
            const char* a1 = cA + (size_t)(t + 1) * kstep;
            const char* a2 = last ? nA : cA + (size_t)(t + 2) * kstep; const char* b2 = last ? nB : cB + (size_t)(t + 2) * kstep;
            const char* a3 = a2 + kstep; const char* b3 = b2 + kstep;
            if (last && has_next) S.a_ready(nxt);
            if constexpr (Epi::ROWSCALE) { if (last) E.prefetch(rsv, cur, wr, fr); }
            if constexpr (SP2) {
            PG8_LDB(B0, 0, 0); PG8_LDB(B1, 0, 1); PG8_SCHED; PG8_LDA(At, 0, 0); PG8_STAGE(PG8_SA(1, 1), a1 + hstep, voffA);
            PG8_WAIT_V(8); PG8_WAIT_L(0); PG8_BAR; PG8_MMA(0, 0, At, B0); PG8_MMA(0, 1, At, B1); PG8_BAR; PG8_SCHED;
            PG8_LDA(At, 0, 1); PG8_STAGE(PG8_SB(0, 0), b2, voffB); PG8_STAGE(PG8_SB(0, 1), b2 + hstep, voffB); PG8_STAGE(PG8_SA(0, 0), a2, voffA);
            PG8_WAIT_V(8); PG8_WAIT_L(0); PG8_BAR; PG8_MMA(1, 0, At, B0); PG8_MMA(1, 1, At, B1); PG8_BAR; PG8_SCHED;
            PG8_LDB(B0, 1, 0); PG8_LDB(B1, 1, 1); PG8_SCHED; PG8_LDA(At, 1, 0); PG8_STAGE(PG8_SA(0, 1), a2 + hstep, voffA);
            PG8_WAIT_V(8); PG8_WAIT_L(0); PG8_BAR; PG8_MMA(0, 0, At, B0); PG8_MMA(0, 1, At, B1); PG8_BAR; PG8_SCHED;
            PG8_LDA(At, 1, 1); PG8_STAGE(PG8_SB(1, 0), b3, voffB); PG8_STAGE(PG8_SB(1, 1), b3 + hstep, voffB); PG8_STAGE(PG8_SA(1, 0), a3, voffA);
            PG8_WAIT_V(8); PG8_WAIT_L(0); PG8_BAR; PG8_MMA(1, 0, At, B0); PG8_MMA(1, 1, At, B1); PG8_BAR; PG8_SCHED;
            } else {
            PG8_LDB(B0, 0, 0); PG8_SCHED; PG8_LDA(At, 0, 0); PG8_STAGE(PG8_SA(1, 1), a1 + hstep, voffA);
            PG8_WAIT_L(8); PG8_BAR; PG8_WAIT_L(0); PG8_MMA(0, 0, At, B0); PG8_BAR; PG8_SCHED;
            PG8_LDB(B1, 0, 1); PG8_STAGE(PG8_SB(0, 0), b2, voffB);
            PG8_BAR; PG8_WAIT_L(0); PG8_MMA(0, 1, At, B1); PG8_BAR;
            PG8_LDA(At, 0, 1); PG8_STAGE(PG8_SA(0, 0), a2, voffA);
            PG8_BAR; PG8_WAIT_L(0); PG8_MMA(1, 0, At, B0); PG8_BAR; PG8_SCHED;
            PG8_STAGE(PG8_SB(0, 1), b2 + hstep, voffB);
            PG8_WAIT_V(6); PG8_BAR; PG8_MMA(1, 1, At, B1); PG8_BAR;
            PG8_LDB(B0, 1, 0); PG8_SCHED; PG8_LDA(At, 1, 0); PG8_STAGE(PG8_SA(0, 1), a2 + hstep, voffA);
            PG8_WAIT_L(8); PG8_BAR; PG8_WAIT_L(0); PG8_MMA(0, 0, At, B0); PG8_BAR; PG8_SCHED;
            PG8_LDB(B1, 1, 1); PG8_STAGE(PG8_SB(1, 0), b3, voffB);
            PG8_BAR; PG8_WAIT_L(0); PG8_MMA(0, 1, At, B1); PG8_BAR;
            PG8_LDA(At, 1, 1); PG8_STAGE(PG8_SA(1, 0), a3, voffA);
            PG8_BAR; PG8_WAIT_L(0); PG8_MMA(1, 0, At, B0); PG8_BAR; PG8_SCHED;
            PG8_STAGE(PG8_SB(1, 1), b3 + hstep, voffB);
            PG8_WAIT_V(6); PG8_BAR; PG8_MMA(1, 1, At, B1); PG8_BAR;
            }
        }
        if constexpr (ALIGN_EPI) { if (wr == 0) PG8_BAR; }
        if constexpr (!Epi::AFTER_DRAIN && !NOEPI) { if constexpr (Epi::ROWSCALE) E(acc, cur, wr, wc, fr, fq, rsv); else E(acc, cur, wr, wc, fr, fq); S.done(cur); }
        if constexpr (NOEPI) { f32x4 sacc = (f32x4){0.f, 0.f, 0.f, 0.f};
#pragma unroll
            for (int a = 0; a < 2; ++a)
#pragma unroll
                for (int bb = 0; bb < 2; ++bb)
#pragma unroll
                    for (int m = 0; m < 4; ++m)
#pragma unroll
                        for (int n = 0; n < 2; ++n) sacc += acc[a][bb][m][n];
            asm volatile("" :: "v"(sacc)); }
        if (!has_next) break;
#pragma unroll
        for (int a = 0; a < 2; ++a)
#pragma unroll
            for (int b = 0; b < 2; ++b)
#pragma unroll
                for (int m = 0; m < 4; ++m)
#pragma unroll
                    for (int n = 0; n < 2; ++n) acc[a][b][m][n] = (f32x4){0.f, 0.f, 0.f, 0.f};
        cur = nxt; cA = nA; cB = nB; ++ui;
        if constexpr (ALIGN_EPI) { if (wr == 1) PG8_BAR; }
    }
    PG8_WAIT_V(0);
    if constexpr (!ALIGN_EPI) { if (wr == 0) PG8_BAR; }
    PG8_BAR;
    if constexpr (Epi::AFTER_DRAIN) { E.fused(acc, cur, wr, wc, fr, fq, lds, wid, lane); S.done(cur); }
#undef PG8_SA
#undef PG8_SB
#undef PG8_STAGE
#undef PG8_LDA
#undef PG8_LDB
#undef PG8_MMA
#undef PG8_WAIT_V
#undef PG8_WAIT_L
#undef PG8_BAR
#undef PG8_SCHED
}
}
#define GAS __attribute__((address_space(1)))
#define LAS __attribute__((address_space(3)))
typedef unsigned short bf16;
typedef unsigned v4u __attribute__((ext_vector_type(4)));
typedef float f32x4 __attribute__((ext_vector_type(4)));
typedef short bf16x8 __attribute__((ext_vector_type(8)));
typedef GAS unsigned gu32;
typedef GAS unsigned long long gu64;
#define RLX_AGENT __ATOMIC_RELAXED, __HIP_MEMORY_SCOPE_AGENT
#define LDS_WAIT() asm volatile("s_waitcnt lgkmcnt(0)" ::: "memory")
#define VM_WAIT() asm volatile("s_waitcnt vmcnt(0)" ::: "memory")
__device__ __forceinline__ unsigned long long rt() { return __builtin_amdgcn_s_memrealtime(); }
__device__ __forceinline__ unsigned f2bf(float f) { unsigned u = __builtin_bit_cast(unsigned, f); return (u + 0x7fffu + ((u >> 16) & 1u)) >> 16; }
__device__ __forceinline__ unsigned pk2(float lo, float hi) { return f2bf(lo) | (f2bf(hi) << 16); }

#define XB_TMO      128
#define XB_XCNT(j)  (256  + 64 * (j))
#define XB_XSUB(j)  (1280 + 64 * (j))
#define XB_XGEN(j)  (2304 + 64 * (j))
#define XB_TOP      3328
#define XB_TOPGEN   3392
#define XCD_BAR_WORDS 3456
#define XB_SPIN_CAP (1u << 18)

__device__ __forceinline__ unsigned xb_ld(unsigned* p)              { return __hip_atomic_load(p, __ATOMIC_RELAXED, __HIP_MEMORY_SCOPE_AGENT); }
__device__ __forceinline__ unsigned xb_add(unsigned* p, unsigned v) { return __hip_atomic_fetch_add(p, v, __ATOMIC_RELAXED, __HIP_MEMORY_SCOPE_AGENT); }
__device__ __forceinline__ unsigned xb_xcc_id() { return (unsigned)__builtin_amdgcn_s_getreg((3 << 11) | 20) & 0xFu; }
#define XB_SPIN(cond, bar) do { unsigned _sp = 0; while (cond) { __builtin_amdgcn_s_sleep(1); \
    if ((++_sp & 255u) == 0u) { if (xb_ld(&(bar)[XB_TMO])) break; if (_sp > XB_SPIN_CAP) { atomicAdd(&(bar)[XB_TMO], 1u); break; } } } } while (0)

struct XcdBarrier {
    unsigned* bar; unsigned x;
    volatile LAS unsigned* st;
};

__device__ __forceinline__ XcdBarrier xcd_barrier_post(unsigned* bar, volatile LAS unsigned* st) {
    XcdBarrier b; b.bar = bar; b.x = xb_xcc_id(); b.st = st;
    if (threadIdx.x == 0) (void)xb_add(&bar[XB_XCNT(b.x)], 1u);
    return b;
}
__device__ __forceinline__ void xcd_barrier_complete(unsigned* bar, unsigned x, unsigned& nloc, unsigned& nx) {
    const unsigned G = gridDim.x * gridDim.y * gridDim.z;
    unsigned sum, cnt, mine, sp = 0u;
    for (;;) {
        sum = 0u; cnt = 0u; mine = 0u;
#pragma unroll
        for (unsigned j = 0; j < 16; ++j) { const unsigned c = xb_ld(&bar[XB_XCNT(j)]); sum += c; cnt += (c > 0u) ? 1u : 0u; mine = (j == x) ? c : mine; }
        if (sum == G) break;
        __builtin_amdgcn_s_sleep(1);
        if ((++sp & 255u) == 0u) { if (xb_ld(&bar[XB_TMO])) break; if (sp > XB_SPIN_CAP) { atomicAdd(&bar[XB_TMO], 1u); break; } }
    }
    nloc = mine > 0u ? mine : 1u; nx = cnt > 0u ? cnt : 1u;
}

__device__ __forceinline__ void xcd_barrier(const XcdBarrier& b) {
    asm volatile("s_waitcnt vmcnt(0)" ::: "memory");
    __syncthreads();
    if (threadIdx.x == 0) {
        unsigned* bar = b.bar;
        __builtin_amdgcn_s_waitcnt(0);
        unsigned nloc = b.st[0], nx = b.st[1];
        if (nloc == 0u) { xcd_barrier_complete(bar, b.x, nloc, nx); b.st[0] = nloc; b.st[1] = nx; }
        const unsigned old = xb_add(&bar[XB_XSUB(b.x)], 1u);
        const unsigned gen = old / nloc;
        if (old + 1u == (gen + 1u) * nloc) {
            __builtin_amdgcn_fence(__ATOMIC_RELEASE, "agent");
            asm volatile("s_waitcnt vmcnt(0)" ::: "memory");
            const unsigned og = xb_add(&bar[XB_TOP], 1u);
            const unsigned tg = og / nx;
            if (og + 1u == (tg + 1u) * nx) xb_add(&bar[XB_TOPGEN], 1u);
            else XB_SPIN(xb_ld(&bar[XB_TOPGEN]) == tg, bar);
            __builtin_amdgcn_fence(__ATOMIC_ACQUIRE, "agent");
            xb_add(&bar[XB_XGEN(b.x)], 1u);
            asm volatile("s_waitcnt vmcnt(0)" ::: "memory");
        } else {
            XB_SPIN(xb_ld(&bar[XB_XGEN(b.x)]) == gen, bar);
            __builtin_amdgcn_fence(__ATOMIC_ACQUIRE, "agent");
            asm volatile("s_waitcnt vmcnt(0)" ::: "memory");
        }
    }
    __syncthreads();
}


constexpr int NWAVES = 8;
constexpr int BATCH = 16, SEQ = 2048, D = 2048, DEPTH = 4, M = BATCH * SEQ;
constexpr int HG_PROJ = 8192, HG_HEADS = 16, HG_K = 128;
constexpr int GM_PROJ = 4096, GM_G = 16, GM_C = 128;
constexpr int FF = 5632, PLE = 256;
constexpr float EPS = 1e-6f;
constexpr int NPHASE = 1 + 9 * DEPTH;

#ifndef DIS_GMLP
#define DIS_GMLP 0
#endif
#ifndef DIS_HGRN
#define DIS_HGRN 0
#endif
#ifndef DIS_THIN
#define DIS_THIN 0
#endif
#ifndef NLOOP
#define NLOOP DEPTH
#endif
#ifndef DUP_MASK
#define DUP_MASK 0
#endif
#define DUP(n) (((DUP_MASK) >> (n)) & 1)
#ifndef HG_FILTER
#define HG_FILTER(t0, t) true
#endif
#ifndef HG_BOTH
#define HG_BOTH 0
#endif
#ifndef PG_ALIGN
#define PG_ALIGN true
#endif
#ifndef PG_SP2
#define PG_SP2 true
#endif
#ifndef THIN_NT
#define THIN_NT 1
#endif
#ifndef NT_G1H
#define NT_G1H 0
#endif
#ifndef NT_G1G
#define NT_G1G 0
#endif
#ifndef GMLP_NAIVE
#define GMLP_NAIVE 0
#endif
#ifndef HGRN_NAIVE
#define HGRN_NAIVE 0
#endif
#ifndef EN_MASK
#define EN_MASK 0xff
#endif
#define EN(n) (((EN_MASK) >> (n)) & 1)
#ifndef MK_ONE_LAUNCH
#define MK_ONE_LAUNCH 1
#endif

constexpr size_t MiB = 1u << 20;
constexpr size_t WS_CTL = 0, CTL_ZERO_BYTES = 65536;
constexpr size_t WS_W1 = 1 * MiB;
constexpr size_t WS_W2 = 33 * MiB;
constexpr size_t WS_WGU = 41 * MiB;
constexpr size_t WS_WD = 85 * MiB;
constexpr size_t WS_WPG = 107 * MiB;
constexpr size_t WS_WPP = 115 * MiB;
constexpr size_t WS_PB = 116 * MiB;
constexpr size_t WS_WST = 132 * MiB;
constexpr size_t WS_WSB = 133 * MiB;
constexpr size_t WS_RS = 133 * MiB + 512 * 1024;
constexpr size_t WS_A = 134 * MiB;
constexpr size_t WS_BIG = 262 * MiB;
constexpr size_t WS_MO = 774 * MiB;
constexpr size_t WS_END = 1030 * MiB;
constexpr int CW_BAR = 4096;

constexpr int RING_OFF = 0, RING_BYTES = 131072;
constexpr int LDSCTL_OFF = RING_BYTES, MISC_OFF = LDSCTL_OFF + 320, XTRA_OFF = LDSCTL_OFF + 1024;
constexpr int LDS_BYTES = 147456;

typedef unsigned v2u __attribute__((ext_vector_type(2)));
#if LBAR_SYNC
#define LBAR() __syncthreads()
#else
#define LBAR() do { asm volatile("s_waitcnt lgkmcnt(0)" ::: "memory"); __builtin_amdgcn_s_barrier(); asm volatile("" ::: "memory"); } while (0)
#endif
__device__ __forceinline__ float wave_sum(float v) {
#pragma unroll
    for (int o = 1; o < 64; o <<= 1) v += __shfl_xor(v, o);
    return v;
}
__device__ __forceinline__ float dot4(f32x4 a) { return (a.x * a.x + a.y * a.y) + (a.z * a.z + a.w * a.w); }
__device__ __forceinline__ float bf2f(unsigned short b) { return __builtin_bit_cast(float, ((unsigned)b) << 16); }
__device__ __forceinline__ float bfw(unsigned w, int hi) { return __builtin_bit_cast(float, hi ? (w & 0xffff0000u) : (w << 16)); }
__device__ __forceinline__ float sigm(float x) { return 1.0f / (1.0f + __expf(-x)); }

struct TItem { const float* W; bf16* WT; int K, N, mode, item; const float* ks; };
__device__ __forceinline__ void titem_load(const TItem& t, float (&v)[32], int lane) {
    const int nblk = t.N / 32, kb = t.item / nblk, nb = t.item % nblk, k0 = 64 * kb, n0 = 32 * nb;
    const float* src = t.W + (size_t)(k0 + (lane >> 5)) * t.N + n0 + (lane & 31);
#pragma unroll
    for (int i = 0; i < 32; ++i) v[i] = *(const GAS float*)(src + (size_t)(2 * i) * t.N);
}
__device__ __forceinline__ void titem_finish(const TItem& t, const float (&v)[32], LAS float* scr, int lane) {
    const int nblk = t.N / 32, kb = t.item / nblk, nb = t.item % nblk, k0 = 64 * kb, n0 = 32 * nb;
    const int d0 = t.mode == 0 ? n0 : ((n0 >> 7) * 256 + (n0 & 127) + (t.mode == 2 ? 128 : 0));
#pragma unroll
    for (int i = 0; i < 32; ++i) scr[(2 * i + (lane >> 5)) * 33 + (lane & 31)] = v[i];
    LDS_WAIT(); asm volatile("" ::: "memory");
    const int c = lane & 7;
    f32x4 ks0 = (f32x4){1.f, 1.f, 1.f, 1.f}, ks1 = ks0;
    if (t.ks) { ks0 = *(const GAS f32x4*)(t.ks + k0 + 8 * c); ks1 = *(const GAS f32x4*)(t.ks + k0 + 8 * c + 4); }
#pragma unroll
    for (int j = 0; j < 4; ++j) { const int n = (lane >> 3) + 8 * j; const LAS float* s = scr + (8 * c) * 33 + n;
        v4u o; o.x = pk2(s[0 * 33] * ks0.x, s[1 * 33] * ks0.y); o.y = pk2(s[2 * 33] * ks0.z, s[3 * 33] * ks0.w); o.z = pk2(s[4 * 33] * ks1.x, s[5 * 33] * ks1.y); o.w = pk2(s[6 * 33] * ks1.z, s[7 * 33] * ks1.w);
        *(GAS v4u*)(t.WT + (size_t)(d0 + n) * t.K + k0 + 8 * c) = o; }
    LDS_WAIT(); asm volatile("" ::: "memory");
}

struct In { const float* p[22]; };

__device__ __forceinline__ void convert_layer(const In& in, unsigned char* ws, int L, LAS unsigned char* lds, int gw, int NGW, int wave, int lane) {
    asm volatile("" : "+v"(lane));
    LAS float* scr = (LAS float*)(lds + RING_OFF + wave * 16384);
    const int j = L >> 1;
    const bool odd = (L & 1) != 0;
    const float* w1 = odd ? in.p[6] + (size_t)j * D * GM_PROJ : in.p[2] + (size_t)j * D * HG_PROJ;
    const int n1 = odd ? GM_PROJ : HG_PROJ;
    const float* w2 = odd ? in.p[11] + (size_t)j * D * D : in.p[5] + (size_t)j * D * D;
    const float* wg = in.p[16] + (size_t)L * D * FF; const float* wu = in.p[17] + (size_t)L * D * FF; const float* wd = in.p[18] + (size_t)L * FF * D;
    const float* wpp = in.p[19] + (size_t)L * PLE * D; const float* wpg = in.p[20] + (size_t)L * D * D;
    const int I1 = (D / 64) * (n1 / 32), I2 = (D / 64) * (D / 32), IG = (D / 64) * (FF / 32), ID = (FF / 64) * (D / 32), IPP = (PLE / 64) * (D / 32);
    const int NITEMS = I1 + I2 + 2 * IG + ID + I2 + IPP;
#define CV_ITEM(t, it_) do { int r = (it_); \
        if (r < I1) { t = TItem{w1, (bf16*)(ws + WS_W1), D, n1, 0, r, in.p[12] + L * D}; break; } r -= I1; \
        if (r < I2) { t = TItem{w2, (bf16*)(ws + WS_W2), D, D, 0, r, nullptr}; break; } r -= I2; \
        if (r < IG) { t = TItem{wg, (bf16*)(ws + WS_WGU), D, FF, 1, r, in.p[14] + L * D}; break; } r -= IG; \
        if (r < IG) { t = TItem{wu, (bf16*)(ws + WS_WGU), D, FF, 2, r, in.p[14] + L * D}; break; } r -= IG; \
        if (r < ID) { t = TItem{wd, (bf16*)(ws + WS_WD), FF, D, 0, r, nullptr}; break; } r -= ID; \
        if (r < I2) { t = TItem{wpg, (bf16*)(ws + WS_WPG), D, D, 0, r, nullptr}; break; } r -= I2; \
        t = TItem{wpp, (bf16*)(ws + WS_WPP), PLE, D, 0, r, nullptr}; } while (0)
    for (int it = gw; it < NITEMS; it += 2 * NGW) {
        TItem t0, t1; float v0[32], v1[32]; const bool has1 = (it + NGW < NITEMS);
        CV_ITEM(t0, it); titem_load(t0, v0, lane);
        if (has1) { CV_ITEM(t1, it + NGW); titem_load(t1, v1, lane); }
        titem_finish(t0, v0, scr, lane);
        if (has1) titem_finish(t1, v1, scr, lane);
    }
#undef CV_ITEM
    { const float* ps = in.p[1] + (size_t)L * M * PLE; bf16* pb = (bf16*)(ws + WS_PB);
      for (size_t i = (size_t)gw * 64 + lane; i < (size_t)M * PLE / 8; i += (size_t)NGW * 64) {
          const f32x4 a = *(const GAS f32x4*)(ps + i * 8), b = *(const GAS f32x4*)(ps + i * 8 + 4);
          v4u o; o.x = pk2(a.x, a.y); o.y = pk2(a.z, a.w); o.z = pk2(b.x, b.y); o.w = pk2(b.z, b.w);
          *(GAS v4u*)(pb + i * 8) = o; } }
    if (odd) {
        const float* wsrc = in.p[9] + (size_t)j * GM_G * GM_C * GM_C; float* wst = (float*)(ws + WS_WST);
        for (int i = gw * 64 + lane; i < GM_G * GM_C * GM_C; i += NGW * 64) { const int t = i & 127, s = (i >> 7) & 127, g = i >> 14;
            wst[i] = (s <= t) ? wsrc[(g * GM_C + t) * GM_C + s] : 0.f; }
        bf16* wsb = (bf16*)(ws + WS_WSB);
        for (int i = gw * 64 + lane; i < GM_G * GM_C * GM_C; i += NGW * 64) { const int s2 = i & 127, t2 = (i >> 7) & 127; wsb[i] = (bf16)((s2 <= t2) ? f2bf(wsrc[i]) : 0u); }
    }
}

__device__ __forceinline__ void rows_to_bf16_rs(const float* x, bf16* H, float* rs, int gw, int NGW, int lane) {
    for (int m = gw; m < M; m += NGW) {
        const GAS f32x4* xr = (const GAS f32x4*)(x + (size_t)m * D) + 2 * lane;
        f32x4 v[8]; float ss = 0.f;
#pragma unroll
        for (int j = 0; j < 4; ++j) { v[2 * j] = xr[128 * j]; v[2 * j + 1] = xr[128 * j + 1]; ss += dot4(v[2 * j]) + dot4(v[2 * j + 1]); }
        const float rstd = __builtin_amdgcn_rsqf(wave_sum(ss) * (1.f / D) + EPS);
        GAS v4u* o16 = (GAS v4u*)(H + (size_t)m * D) + lane;
#pragma unroll
        for (int j = 0; j < 4; ++j) { const f32x4 a0 = v[2 * j], a1 = v[2 * j + 1]; o16[64 * j] = (v4u){pk2(a0.x, a0.y), pk2(a0.z, a0.w), pk2(a1.x, a1.y), pk2(a1.z, a1.w)}; }
        if (lane == 0) ((_Float16*)rs)[pg8::rs_slot(m)] = (_Float16)rstd;
    }
}
struct ThinRow { f32x4 hv[8]; v4u hw[4]; v4u mw[4]; };
template <bool HIN_F32>
__device__ __forceinline__ void thin_load(ThinRow& r, const void* hin, const bf16* mo, int m, int lane) {
    const GAS v4u* mr = (const GAS v4u*)(mo + (size_t)m * D) + lane;
    if (HIN_F32) { const GAS f32x4* hr = (const GAS f32x4*)((const float*)hin + (size_t)m * D) + 2 * lane;
#pragma unroll
        for (int j = 0; j < 4; ++j) { r.mw[j] = THIN_NT ? __builtin_nontemporal_load(mr + 64 * j) : mr[64 * j]; r.hv[2 * j] = hr[128 * j]; r.hv[2 * j + 1] = hr[128 * j + 1]; } }
    else { const GAS v4u* hr = (const GAS v4u*)((const bf16*)hin + (size_t)m * D) + lane;
#pragma unroll
        for (int j = 0; j < 4; ++j) { r.mw[j] = THIN_NT ? __builtin_nontemporal_load(mr + 64 * j) : mr[64 * j]; r.hw[j] = (THIN_NT > 1) ? __builtin_nontemporal_load(hr + 64 * j) : hr[64 * j]; } }
}
template <bool HIN_F32, bool HOUT_F32, bool NORM_A>
__device__ __forceinline__ void thin_proc(ThinRow& r, const float* gpost, const float* gnext, void* hout, float* A, int m, int lane) {
    f32x4 mv[8]; float ss = 0.f;
#pragma unroll
    for (int j = 0; j < 4; ++j) { const v4u w = r.mw[j];
        mv[2 * j] = (f32x4){bfw(w.x, 0), bfw(w.x, 1), bfw(w.y, 0), bfw(w.y, 1)}; mv[2 * j + 1] = (f32x4){bfw(w.z, 0), bfw(w.z, 1), bfw(w.w, 0), bfw(w.w, 1)};
        ss += dot4(mv[2 * j]) + dot4(mv[2 * j + 1]);
        if (!HIN_F32) { const v4u hw = r.hw[j]; r.hv[2 * j] = (f32x4){bfw(hw.x, 0), bfw(hw.x, 1), bfw(hw.y, 0), bfw(hw.y, 1)}; r.hv[2 * j + 1] = (f32x4){bfw(hw.z, 0), bfw(hw.z, 1), bfw(hw.w, 0), bfw(hw.w, 1)}; } }
    const float rstd = __builtin_amdgcn_rsqf(wave_sum(ss) * (1.f / D) + EPS);
    float ss2 = 0.f;
#pragma unroll
    for (int j = 0; j < 4; ++j) {
#pragma unroll
        for (int h2 = 0; h2 < 2; ++h2) { const f32x4 gg = ((const GAS f32x4*)gpost)[2 * lane + 128 * j + h2]; r.hv[2 * j + h2] = r.hv[2 * j + h2] + mv[2 * j + h2] * rstd * gg; ss2 += dot4(r.hv[2 * j + h2]); }
        if (HOUT_F32) { GAS f32x4* ho = (GAS f32x4*)((float*)hout + (size_t)m * D) + 2 * lane; ho[128 * j] = r.hv[2 * j]; ho[128 * j + 1] = r.hv[2 * j + 1]; }
        else { GAS v4u* ho = (GAS v4u*)((bf16*)hout + (size_t)m * D) + lane; const f32x4 a0 = r.hv[2 * j], a1 = r.hv[2 * j + 1]; ho[64 * j] = (v4u){pk2(a0.x, a0.y), pk2(a0.z, a0.w), pk2(a1.x, a1.y), pk2(a1.z, a1.w)}; } }
    if (NORM_A) { const float r2 = __builtin_amdgcn_rsqf(wave_sum(ss2) * (1.f / D) + EPS); if (lane == 0) ((_Float16*)A)[pg8::rs_slot(m)] = (_Float16)r2; }
}
template <bool HIN_F32, bool HOUT_F32, bool NORM_A>
__device__ __forceinline__ void thin_phase(const void* hin, const bf16* mo, const float* gpost, const float* gnext, void* hout, float* A, int gw, int NGW, int lane) {
    asm volatile("" : "+v"(lane));
    ThinRow r0, r1;
    if (gw < M) thin_load<HIN_F32>(r0, hin, mo, gw, lane);
    for (int m = gw; m < M; m += 2 * NGW) {
        const bool has1 = (m + NGW < M);
        if (has1) thin_load<HIN_F32>(r1, hin, mo, m + NGW, lane);
        thin_proc<HIN_F32, HOUT_F32, NORM_A>(r0, gpost, gnext, hout, A, m, lane);
        if (m + 2 * NGW < M) thin_load<HIN_F32>(r0, hin, mo, m + 2 * NGW, lane);
        if (has1) thin_proc<HIN_F32, HOUT_F32, NORM_A>(r1, gpost, gnext, hout, A, m + NGW, lane);
    }
}

__device__ __forceinline__ void hgrn_naive_phase(const bf16* proj, const float* lb_logits, int j, const float* out_norm, bf16* Y, LAS unsigned char* lds, int tid, int G) {
    asm volatile("" : "+v"(tid));
    LAS float* Q = (LAS float*)(lds);
    LAS float* F = Q + 2048; LAS float* KK = F + 2048; LAS float* V = KK + 2048; LAS float* Gt = V + 2048;
    LAS float* Po = Gt + 2048;
    const int tok = tid >> 5, c4 = (tid & 31) * 4, v = tid & 127, kg = tid >> 7;
    for (int u = blockIdx.x; u < BATCH * HG_HEADS; u += G) {
        const int b = u / HG_HEADS, hd = u % HG_HEADS;
        float lb[4], lbf[4], onw[4];
#pragma unroll
        for (int i = 0; i < 4; ++i) { const int ch = hd * HG_K + c4 + i; const float l0 = lb_logits[ch], l1 = lb_logits[2048 + ch];
            lb[i] = (j == 0) ? 0.f : 1.0f / (1.0f + __expf(l0 - l1)); lbf[i] = fmaxf(lb[i], 1e-30f); onw[i] = out_norm[c4 + i]; }
        float S[32];
#pragma unroll
        for (int i = 0; i < 32; ++i) S[i] = 0.f;
        for (int t0 = 0; t0 < SEQ; t0 += 16) {
            { const size_t row = (size_t)b * SEQ + t0 + tok; const bf16* pr = proj + row * HG_PROJ + hd * HG_K + c4;
              const v2u zq = *(const GAS v2u*)(pr), zf = *(const GAS v2u*)(pr + 2048), zi = *(const GAS v2u*)(pr + 4096), zg = *(const GAS v2u*)(pr + 6144);
              const unsigned qw[2] = {zq.x, zq.y}, fw[2] = {zf.x, zf.y}, iw[2] = {zi.x, zi.y}, gw2[2] = {zg.x, zg.y};
              f32x4 qv, fv, kv, vv, gv;
#pragma unroll
              for (int i = 0; i < 4; ++i) { const float a = bfw(qw[i >> 1], i & 1); qv[i] = a * sigm(a); const float z = bfw(fw[i >> 1], i & 1); fv[i] = lbf[i] + (1.0f - lb[i]) * sigm(z); kv[i] = (1.0f - lb[i]) * sigm(-z); vv[i] = bfw(iw[i >> 1], i & 1); gv[i] = bfw(gw2[i >> 1], i & 1); }
              const int o = tok * 128 + c4;
              *(LAS f32x4*)(Q + o) = qv; *(LAS f32x4*)(F + o) = fv; *(LAS f32x4*)(KK + o) = kv; *(LAS f32x4*)(V + o) = vv; *(LAS f32x4*)(Gt + o) = gv; }
            __syncthreads();
            for (int t = 0; t < 16; ++t) {
                const float vt = V[t * 128 + v]; float po = 0.f;
#pragma unroll
                for (int i4 = 0; i4 < 8; ++i4) { const int o = t * 128 + kg * 32 + i4 * 4; const f32x4 f4 = *(const LAS f32x4*)(F + o), k4 = *(const LAS f32x4*)(KK + o), q4 = *(const LAS f32x4*)(Q + o);
#pragma unroll
                    for (int e = 0; e < 4; ++e) { S[i4 * 4 + e] = f4[e] * S[i4 * 4 + e] + k4[e] * vt; po += S[i4 * 4 + e] * q4[e]; } }
                Po[(t * 4 + kg) * 128 + v] = po;
            }
            __syncthreads();
            { f32x4 o4 = *(const LAS f32x4*)(Po + (tok * 4 + 0) * 128 + c4);
#pragma unroll
              for (int g2 = 1; g2 < 4; ++g2) o4 = o4 + *(const LAS f32x4*)(Po + (tok * 4 + g2) * 128 + c4);
              float ss = dot4(o4);
#pragma unroll
              for (int o = 1; o < 32; o <<= 1) ss += __shfl_xor(ss, o);
              const float rstd = 1.0f / sqrtf(ss * (1.f / 128.f) + EPS);
              const f32x4 gv = *(const LAS f32x4*)(Gt + tok * 128 + c4);
              float y[4];
#pragma unroll
              for (int i = 0; i < 4; ++i) y[i] = o4[i] * rstd * onw[i] * (gv[i] * sigm(gv[i]));
              const size_t row = (size_t)b * SEQ + t0 + tok;
              *(GAS unsigned long long*)(Y + row * D + hd * HG_K + c4) = (unsigned long long)pk2(y[0], y[1]) | ((unsigned long long)pk2(y[2], y[3]) << 32); }
            __syncthreads();
        }
    }
}

__device__ __forceinline__ void gmlp_naive_phase(const bf16* z, const float* ln_g, const float* ln_b, const float* wst, const float* b_s, bf16* Y, LAS unsigned char* lds, int tid, int G) {
    asm volatile("" : "+v"(tid));
    LAS float* Vn = (LAS float*)(lds);
    LAS float* WT = Vn + 16384;
    LAS float* ST = (LAS float*)(lds + XTRA_OFF);
    const int lane = tid & 63, wave = tid >> 6;
    for (int u = blockIdx.x; u < BATCH * (SEQ / GM_C); u += G) {
        const size_t row0 = (size_t)u * GM_C;
        for (int r = wave * 16; r < wave * 16 + 16; ++r) {
            const bf16* vr = z + (row0 + r) * GM_PROJ + 2048 + lane * 8;
            float x[32]; float s = 0.f;
#pragma unroll
            for (int jj = 0; jj < 4; ++jj) { const v4u w = *(const GAS v4u*)(vr + 512 * jj); const unsigned ww[4] = {w.x, w.y, w.z, w.w};
#pragma unroll
                for (int e = 0; e < 4; ++e) { x[jj * 8 + 2 * e] = __builtin_bit_cast(float, ww[e] << 16); x[jj * 8 + 2 * e + 1] = __builtin_bit_cast(float, ww[e] & 0xffff0000u); s += x[jj * 8 + 2 * e] + x[jj * 8 + 2 * e + 1]; } }
            const float mean = wave_sum(s) * (1.f / 2048.f); float q = 0.f;
#pragma unroll
            for (int e = 0; e < 32; ++e) { const float d = x[e] - mean; q += d * d; }
            const float rstd = 1.0f / sqrtf(wave_sum(q) * (1.f / 2048.f) + EPS);
            if (lane == 0) { ST[2 * r] = mean; ST[2 * r + 1] = rstd; }
        }
        __syncthreads();
        for (int g = 0; g < GM_G; ++g) {
#pragma unroll
            for (int i = 0; i < 4; ++i) { const int s = (tid >> 4) + 32 * i, c8 = (tid & 15) * 8;
                const v4u w = *(const GAS v4u*)(z + (row0 + s) * GM_PROJ + 2048 + g * GM_C + c8); const unsigned ww[4] = {w.x, w.y, w.z, w.w};
                const float mean = ST[2 * s], rstd = ST[2 * s + 1];
                const f32x4 g0 = *(const GAS f32x4*)(ln_g + g * GM_C + c8), g1 = *(const GAS f32x4*)(ln_g + g * GM_C + c8 + 4), b0 = *(const GAS f32x4*)(ln_b + g * GM_C + c8), b1 = *(const GAS f32x4*)(ln_b + g * GM_C + c8 + 4);
                f32x4 o0, o1;
                o0.x = (__builtin_bit_cast(float, ww[0] << 16) - mean) * rstd * g0.x + b0.x; o0.y = (__builtin_bit_cast(float, ww[0] & 0xffff0000u) - mean) * rstd * g0.y + b0.y;
                o0.z = (__builtin_bit_cast(float, ww[1] << 16) - mean) * rstd * g0.z + b0.z; o0.w = (__builtin_bit_cast(float, ww[1] & 0xffff0000u) - mean) * rstd * g0.w + b0.w;
                o1.x = (__builtin_bit_cast(float, ww[2] << 16) - mean) * rstd * g1.x + b1.x; o1.y = (__builtin_bit_cast(float, ww[2] & 0xffff0000u) - mean) * rstd * g1.y + b1.y;
                o1.z = (__builtin_bit_cast(float, ww[3] << 16) - mean) * rstd * g1.z + b1.z; o1.w = (__builtin_bit_cast(float, ww[3] & 0xffff0000u) - mean) * rstd * g1.w + b1.w;
                *(LAS f32x4*)(Vn + s * 128 + c8) = o0; *(LAS f32x4*)(Vn + s * 128 + c8 + 4) = o1; }
#pragma unroll
            for (int i = 0; i < 8; ++i) { const int e4 = tid + 512 * i; *(LAS f32x4*)(WT + e4 * 4) = *(const GAS f32x4*)(wst + (size_t)g * 16384 + e4 * 4); }
            __syncthreads();
            { int tid2 = tid; asm volatile("" : "+v"(tid2)); const int c = tid2 & 127, tq = tid2 >> 7; float acc[32];
#pragma unroll
              for (int i = 0; i < 32; ++i) acc[i] = 0.f;
              const int smax = tq * 32 + 32;
              for (int s = 0; s < smax; ++s) { const float vn = Vn[s * 128 + c];
#pragma unroll
                  for (int i4 = 0; i4 < 8; ++i4) { const f32x4 w4 = *(const LAS f32x4*)(WT + s * 128 + tq * 32 + i4 * 4);
#pragma unroll
                      for (int e = 0; e < 4; ++e) acc[i4 * 4 + e] += w4[e] * vn; } }
#pragma unroll
              for (int i = 0; i < 32; ++i) { const int t = tq * 32 + i; const size_t row = row0 + t;
                  const float uu = bf2f(z[row * GM_PROJ + g * GM_C + c]); const float yv = uu * (acc[i] + b_s[g * GM_C + t]);
                  Y[row * D + g * GM_C + c] = (bf16)f2bf(yv); } }
            __syncthreads();
        }
    }
}


__device__ __forceinline__ void gmlp_mfma_phase(const bf16* z, const float* ln_g, const float* ln_b, const bf16* wsb, const float* b_s, bf16* Y, LAS unsigned char* lds, int tid, int G) {
    asm volatile("" : "+v"(tid));
    constexpr int VSTR = 272;
    LAS float* ST = (LAS float*)(lds + XTRA_OFF);
    const int lane = tid & 63, wave = __builtin_amdgcn_readfirstlane(tid >> 6);
    const int l15 = lane & 15, lg = lane >> 4;
    for (int u = blockIdx.x; u < BATCH * (SEQ / GM_C); u += G) {
        const size_t row0 = (size_t)u * GM_C;
#pragma unroll 1
        for (int rb = 0; rb < 4; ++rb) {
            v4u raw4[4][4];
#pragma unroll
            for (int q = 0; q < 4; ++q) { const bf16* vr = z + (row0 + wave * 16 + rb * 4 + q) * GM_PROJ + 2048 + lane * 8;
#pragma unroll
                for (int jj = 0; jj < 4; ++jj) raw4[q][jj] = *(const GAS v4u*)(vr + 512 * jj); }
#pragma unroll
            for (int q = 0; q < 4; ++q) { float x[32]; float sm = 0.f;
#pragma unroll
                for (int jj = 0; jj < 4; ++jj) { const v4u w = raw4[q][jj]; const unsigned ww[4] = {w.x, w.y, w.z, w.w};
#pragma unroll
                    for (int e = 0; e < 4; ++e) { x[jj * 8 + 2 * e] = bfw(ww[e], 0); x[jj * 8 + 2 * e + 1] = bfw(ww[e], 1); sm += x[jj * 8 + 2 * e] + x[jj * 8 + 2 * e + 1]; } }
                const float mean = wave_sum(sm) * (1.f / 2048.f); float qq = 0.f;
#pragma unroll
                for (int e = 0; e < 32; ++e) { const float d = x[e] - mean; qq += d * d; }
                const float rstd = __builtin_amdgcn_rsqf(wave_sum(qq) * (1.f / 2048.f) + EPS);
                if (lane == 0) { const int r = wave * 16 + rb * 4 + q; ST[2 * r] = mean; ST[2 * r + 1] = rstd; } }
        }
        const bf16* src0 = z + (row0 + 16 * wave) * GM_PROJ + 2048 + 2 * lane;
        unsigned raw[16];
#pragma unroll
        for (int i = 0; i < 16; ++i) raw[i] = *(const GAS unsigned*)(src0 + (size_t)i * GM_PROJ);
        pg8::f32x2 lg_n = *(const GAS pg8::f32x2*)(ln_g + 2 * lane), lb_n = *(const GAS pg8::f32x2*)(ln_b + 2 * lane);
        LBAR();
        for (int g = 0; g < GM_G; ++g) {
            LAS unsigned char* VT = lds + (g & 1) * (128 * VSTR);
            {
                const int cp = lane;
                const float g0 = lg_n.x, g1 = lg_n.y, b0 = lb_n.x, b1 = lb_n.y;
                if (g + 1 < GM_G) { lg_n = *(const GAS pg8::f32x2*)(ln_g + (g + 1) * GM_C + 2 * lane); lb_n = *(const GAS pg8::f32x2*)(ln_b + (g + 1) * GM_C + 2 * lane); }
                unsigned lo[8], hi[8];
#pragma unroll
                for (int i = 0; i < 8; ++i) { const f32x4 st = *(const LAS f32x4*)(ST + 2 * (16 * wave + 2 * i));
                    const float x00 = (bfw(raw[2 * i], 0) - st.x) * st.y * g0 + b0, x01 = (bfw(raw[2 * i], 1) - st.x) * st.y * g1 + b1;
                    const float x10 = (bfw(raw[2 * i + 1], 0) - st.z) * st.w * g0 + b0, x11 = (bfw(raw[2 * i + 1], 1) - st.z) * st.w * g1 + b1;
                    lo[i] = pk2(x00, x10); hi[i] = pk2(x01, x11); }
                LAS unsigned char* d0 = VT + (2 * cp) * VSTR + 32 * wave;
                *(LAS v4u*)(d0) = (v4u){lo[0], lo[1], lo[2], lo[3]}; *(LAS v4u*)(d0 + 16) = (v4u){lo[4], lo[5], lo[6], lo[7]};
                *(LAS v4u*)(d0 + VSTR) = (v4u){hi[0], hi[1], hi[2], hi[3]}; *(LAS v4u*)(d0 + VSTR + 16) = (v4u){hi[4], hi[5], hi[6], hi[7]};
            }
            if (g + 1 < GM_G) {
#pragma unroll
                for (int i = 0; i < 16; ++i) raw[i] = *(const GAS unsigned*)(src0 + (g + 1) * GM_C + (size_t)i * GM_PROJ);
            }
            const int t = 16 * wave + l15; const size_t row = row0 + t;
            const bf16* up = z + row * GM_PROJ + g * GM_C + 4 * lg;
            v2u uu[8];
#pragma unroll
            for (int ct = 0; ct < 8; ++ct) uu[ct] = *(const GAS v2u*)(up + 16 * ct);
            const float bs = b_s[g * GM_C + t];
            const int nk = (wave >> 1) + 1;
            const bf16* wrow = wsb + ((size_t)g * GM_C + 16 * wave + l15) * GM_C + 8 * lg;
            bf16x8 wf[4];
#pragma unroll
            for (int ks = 0; ks < 4; ++ks) if (ks < nk) wf[ks] = *(const GAS bf16x8*)(wrow + 32 * ks);
            LBAR();
            f32x4 acc[8];
#pragma unroll
            for (int ct = 0; ct < 8; ++ct) acc[ct] = (f32x4){0.f, 0.f, 0.f, 0.f};
#pragma unroll
            for (int ks = 0; ks < 4; ++ks) if (ks < nk) {
#pragma unroll
                for (int ct = 0; ct < 8; ++ct) { const bf16x8 vf = *(const LAS bf16x8*)(VT + (16 * ct + l15) * VSTR + 64 * ks + 16 * lg);
                    acc[ct] = __builtin_amdgcn_mfma_f32_16x16x32_bf16(vf, wf[ks], acc[ct], 0, 0, 0); }
            }
            { bf16* yp = Y + row * D + g * GM_C + 4 * lg;
#pragma unroll
              for (int ct = 0; ct < 8; ++ct) { const unsigned ux = uu[ct].x, uy = uu[ct].y;
                  v2u o; o.x = pk2(bfw(ux, 0) * (acc[ct][0] + bs), bfw(ux, 1) * (acc[ct][1] + bs)); o.y = pk2(bfw(uy, 0) * (acc[ct][2] + bs), bfw(uy, 1) * (acc[ct][3] + bs));
                  *(GAS v2u*)(yp + 16 * ct) = o; } }
        }
        LBAR();
    }
}

typedef __bf16 bf16x2_t __attribute__((ext_vector_type(2)));
__device__ __forceinline__ unsigned cvtpk(float lo, float hi) { const pg8::f32x2 v = {lo, hi}; return __builtin_bit_cast(unsigned, __builtin_convertvector(v, bf16x2_t)); }
__device__ __forceinline__ void hgrn_mfma_phase(const bf16* proj, const float* lb_logits, int j, const float* out_norm, bf16* Y, LAS unsigned char* lds, int tid, int G) {
    asm volatile("" : "+v"(tid));
    constexpr int QS = 272, TS = 80, OS = 528;
    LAS unsigned char* const QT = lds;
    LAS unsigned char* const KT = lds + 8704;
    LAS unsigned char* const KHT = lds + 17408;
    LAS unsigned char* const VT = lds + 27648;
    LAS unsigned char* const AM = lds + 37888;
    LAS unsigned char* const OB = lds + 40448;
    LAS unsigned char* const GT = lds + 57344;
    LAS float* const TOT = (LAS float*)(lds + 65536);
    LAS float* const DL = (LAS float*)(lds + 69632);
    const int lane = tid & 63, wave = __builtin_amdgcn_readfirstlane(tid >> 6), l15 = lane & 15, lg = lane >> 4;
    const int t_o = tid >> 4, v8 = (tid & 15) * 8;
    for (int u = blockIdx.x; u < BATCH * HG_HEADS; u += G) {
        const int b = u / HG_HEADS, hd = u % HG_HEADS;
        float lbf[2], oml[2];
#pragma unroll
        for (int e = 0; e < 2; ++e) { const int ch = hd * HG_K + 2 * lane + e; const float l0 = lb_logits[ch], l1 = lb_logits[2048 + ch];
            const float lb = (j == 0) ? 0.f : 1.0f / (1.0f + __expf(l0 - l1)); lbf[e] = fmaxf(lb, 1e-30f); oml[e] = 1.0f - lb; }
        float onw[8];
#pragma unroll
        for (int i = 0; i < 8; ++i) onw[i] = out_norm[v8 + i];
        f32x4 S[8];
#pragma unroll
        for (int kt = 0; kt < 8; ++kt) S[kt] = (f32x4){0.f, 0.f, 0.f, 0.f};
        const bf16* base = proj + ((size_t)b * SEQ + 4 * wave) * HG_PROJ + hd * HG_K + 2 * lane;
        unsigned rq[4], rf[4], ri[4], rg[4];
#pragma unroll
        for (int i = 0; i < 4; ++i) { const bf16* p = base + (size_t)i * HG_PROJ; rq[i] = *(const GAS unsigned*)p; rf[i] = *(const GAS unsigned*)(p + 2048); ri[i] = *(const GAS unsigned*)(p + 4096); rg[i] = *(const GAS unsigned*)(p + 6144); }
        for (int t0 = 0; t0 < SEQ; t0 += 32) {
            float q[4][2], kk[4][2], cs[4][2];
#pragma unroll
            for (int i = 0; i < 4; ++i)
#pragma unroll
                for (int e = 0; e < 2; ++e) { const float zq = bfw(rq[i], e); q[i][e] = zq * __builtin_amdgcn_rcpf(1.0f + __builtin_amdgcn_exp2f(-1.4426950408889634f * zq));
                    const float zf = fmaxf(bfw(rf[i], e), -80.f); const float en = __builtin_amdgcn_exp2f(-1.4426950408889634f * zf), sg = __builtin_amdgcn_rcpf(1.0f + en);
                    const float lf = __builtin_amdgcn_logf(lbf[e] + oml[e] * sg); kk[i][e] = oml[e] * en * sg; cs[i][e] = (i == 0) ? lf : cs[i - 1][e] + lf; }
            *(LAS pg8::f32x2*)(TOT + wave * 128 + 2 * lane) = (pg8::f32x2){cs[3][0], cs[3][1]};
#pragma unroll
            for (int i = 0; i < 4; ++i) *(LAS unsigned*)(GT + (4 * wave + i) * 256 + 4 * lane) = rg[i];
            *(LAS v2u*)(VT + (2 * lane) * TS + 8 * wave) = (v2u){(ri[0] & 0xffffu) | (ri[1] << 16), (ri[2] & 0xffffu) | (ri[3] << 16)};
            *(LAS v2u*)(VT + (2 * lane + 1) * TS + 8 * wave) = (v2u){(ri[0] >> 16) | (ri[1] & 0xffff0000u), (ri[2] >> 16) | (ri[3] & 0xffff0000u)};
            if (t0 + 32 < SEQ) {
#pragma unroll
                for (int i = 0; i < 4; ++i) { const bf16* p = base + (size_t)(t0 + 32 + i) * HG_PROJ; rq[i] = *(const GAS unsigned*)p; rf[i] = *(const GAS unsigned*)(p + 2048); ri[i] = *(const GAS unsigned*)(p + 4096); rg[i] = *(const GAS unsigned*)(p + 6144); }
            }
            LBAR();
            { float pre[2] = {0.f, 0.f}, tot[2] = {0.f, 0.f};
#pragma unroll
              for (int w2 = 0; w2 < 8; ++w2) { const pg8::f32x2 tv = *(const LAS pg8::f32x2*)(TOT + w2 * 128 + 2 * lane); const float a0 = tv.x, a1 = tv.y;
                  tot[0] += a0; tot[1] += a1; if (w2 < wave) { pre[0] += a0; pre[1] += a1; } }
              float kh[4][2];
#pragma unroll
              for (int i = 0; i < 4; ++i) { float qt[2], kt2[2];
#pragma unroll
                  for (int e = 0; e < 2; ++e) { const float bb = pre[e] + cs[i][e];
                      qt[e] = q[i][e] * __builtin_amdgcn_exp2f(bb); kt2[e] = kk[i][e] * __builtin_amdgcn_exp2f(fminf(-bb, 115.f)); kh[i][e] = kk[i][e] * __builtin_amdgcn_exp2f(tot[e] - bb); }
                  *(LAS unsigned*)(QT + (4 * wave + i) * QS + 4 * lane) = cvtpk(qt[0], qt[1]);
                  *(LAS unsigned*)(KT + (4 * wave + i) * QS + 4 * lane) = cvtpk(kt2[0], kt2[1]); }
              *(LAS v2u*)(KHT + (2 * lane) * TS + 8 * wave) = (v2u){cvtpk(kh[0][0], kh[1][0]), cvtpk(kh[2][0], kh[3][0])};
              *(LAS v2u*)(KHT + (2 * lane + 1) * TS + 8 * wave) = (v2u){cvtpk(kh[0][1], kh[1][1]), cvtpk(kh[2][1], kh[3][1])};
              if (wave == 0) *(LAS pg8::f32x2*)(DL + 2 * lane) = (pg8::f32x2){__builtin_amdgcn_exp2f(tot[0]), __builtin_amdgcn_exp2f(tot[1])}; }
            LBAR();
            if (wave < 3) { const int tt = wave ? 1 : 0, st = (wave == 2) ? 1 : 0; f32x4 am = (f32x4){0.f, 0.f, 0.f, 0.f};
#pragma unroll
                for (int k4 = 0; k4 < 4; ++k4) { const bf16x8 a = *(const LAS bf16x8*)(QT + (16 * tt + l15) * QS + 64 * k4 + 16 * lg); const bf16x8 bq = *(const LAS bf16x8*)(KT + (16 * st + l15) * QS + 64 * k4 + 16 * lg);
                    am = __builtin_amdgcn_mfma_f32_16x16x32_bf16(a, bq, am, 0, 0, 0); }
#pragma unroll
                for (int r = 0; r < 4; ++r) { const int tl = 4 * lg + r; const float val = (tt != st || l15 <= tl) ? am[r] : 0.f;
                    *(LAS unsigned short*)(AM + (16 * tt + tl) * TS + (16 * st + l15) * 2) = (unsigned short)f2bf(val); } }
            else if (wave == 3) {
#pragma unroll
                for (int r = 0; r < 4; ++r) *(LAS unsigned short*)(AM + (4 * lg + r) * TS + (16 + l15) * 2) = (unsigned short)0; }
            f32x4 o[2] = {(f32x4){0.f, 0.f, 0.f, 0.f}, (f32x4){0.f, 0.f, 0.f, 0.f}};
#pragma unroll
            for (int k2 = 0; k2 < 4; ++k2) {
                const v4u sb = (v4u){cvtpk(S[2 * k2][0], S[2 * k2][1]), cvtpk(S[2 * k2][2], S[2 * k2][3]), cvtpk(S[2 * k2 + 1][0], S[2 * k2 + 1][1]), cvtpk(S[2 * k2 + 1][2], S[2 * k2 + 1][3])};
                const bf16x8 sfrag = __builtin_bit_cast(bf16x8, sb);
#pragma unroll
                for (int tt = 0; tt < 2; ++tt) { const LAS unsigned char* qp = QT + (16 * tt + l15) * QS + (32 * k2 + 4 * lg) * 2;
                    const v2u lo = *(const LAS v2u*)qp, hi = *(const LAS v2u*)(qp + 32);
                    const bf16x8 a = __builtin_bit_cast(bf16x8, (v4u){lo.x, lo.y, hi.x, hi.y});
                    o[tt] = __builtin_amdgcn_mfma_f32_16x16x32_bf16(a, sfrag, o[tt], 0, 0, 0); }
            }
            LBAR();
            { const bf16x8 vfrag = *(const LAS bf16x8*)(VT + (16 * wave + l15) * TS + 16 * lg);
#pragma unroll
              for (int tt = 0; tt < 2; ++tt) { const bf16x8 a = *(const LAS bf16x8*)(AM + (16 * tt + l15) * TS + 16 * lg); o[tt] = __builtin_amdgcn_mfma_f32_16x16x32_bf16(a, vfrag, o[tt], 0, 0, 0);
#pragma unroll
                  for (int r = 0; r < 4; ++r) *(LAS float*)(OB + (16 * tt + 4 * lg + r) * OS + (16 * wave + l15) * 4) = o[tt][r]; }
#pragma unroll
              for (int kt = 0; kt < 8; ++kt) { const f32x4 d4 = *(const LAS f32x4*)(DL + 16 * kt + 4 * lg); const bf16x8 a = *(const LAS bf16x8*)(KHT + (16 * kt + l15) * TS + 16 * lg);
                  S[kt] = __builtin_amdgcn_mfma_f32_16x16x32_bf16(a, vfrag, S[kt] * d4, 0, 0, 0); } }
            LBAR();
            { const f32x4 o0 = *(const LAS f32x4*)(OB + t_o * OS + v8 * 4), o1 = *(const LAS f32x4*)(OB + t_o * OS + v8 * 4 + 16);
              float ss = dot4(o0) + dot4(o1);
#pragma unroll
              for (int m = 1; m < 16; m <<= 1) ss += __shfl_xor(ss, m);
              const float rstd = __builtin_amdgcn_rsqf(ss * (1.f / 128.f) + EPS);
              const v4u gr = *(const LAS v4u*)(GT + t_o * 256 + v8 * 2); const unsigned gw4[4] = {gr.x, gr.y, gr.z, gr.w};
              float y[8];
#pragma unroll
              for (int i = 0; i < 8; ++i) { const float gv = bfw(gw4[i >> 1], i & 1); const float ov = (i < 4) ? o0[i & 3] : o1[i & 3]; y[i] = ov * rstd * onw[i] * (gv * __builtin_amdgcn_rcpf(1.0f + __builtin_amdgcn_exp2f(-1.4426950408889634f * gv))); }
              if (HG_FILTER(t0, t_o)) *(GAS v4u*)(Y + ((size_t)b * SEQ + t0 + t_o) * D + hd * HG_K + v8) = (v4u){pk2(y[0], y[1]), pk2(y[2], y[3]), pk2(y[4], y[5]), pk2(y[6], y[7])}; }
            LBAR();
        }
    }
}

struct Args { In in; float* out; unsigned char* ws; int ph_lo, ph_hi; };
__global__ void __launch_bounds__(NWAVES * 64, 2) fwd(Args args) {
    extern __shared__ __attribute__((aligned(16))) unsigned char lds_raw[];
    LAS unsigned char* lds = (LAS unsigned char*)lds_raw;
    volatile LAS unsigned* MISC = (volatile LAS unsigned*)(lds + MISC_OFF);
    const int tid = threadIdx.x, lane = tid & 63, wave = __builtin_amdgcn_readfirstlane(tid >> 6);
    const int G = gridDim.x; const int bx = blockIdx.x; const int vcu = (G % 8 == 0) ? (bx % 8) * (G / 8) + bx / 8 : bx;
    const int gw = vcu * NWAVES + wave, NGW = G * NWAVES;
    unsigned char* ws = args.ws; gu32* ctl = (gu32*)(ws + WS_CTL);
    for (int u = tid; u < (LDS_BYTES - LDSCTL_OFF) / 4; u += NWAVES * 64) ((LAS unsigned*)(lds + LDSCTL_OFF))[u] = 0u;
    __syncthreads();
    XcdBarrier bar; bar.bar = (unsigned*)(ctl + CW_BAR); bar.x = 0; bar.st = nullptr;
    if (MK_ONE_LAUNCH) bar = xcd_barrier_post((unsigned*)(ctl + CW_BAR), MISC + 8);
    const int lo = args.ph_lo, hi = args.ph_hi;
#define IN(k) (lo <= (k) && (k) < hi)
#define SEAM(k) do { if (IN(k) && IN((k) + 1)) { xcd_barrier(bar); if (DUP(12)) xcd_barrier(bar); } } while (0)
    const In& in = args.in;
    bf16* const A = (bf16*)(ws + WS_A); bf16* const BIG = (bf16*)(ws + WS_BIG); bf16* const MO = (bf16*)(ws + WS_MO); bf16* const H16 = (bf16*)(ws + WS_MO + 128 * MiB); float* const RS = (float*)(ws + WS_RS);
    float* const out = args.out;

    if (!DIS_THIN && IN(0)) { convert_layer(in, ws, 0, lds, gw, NGW, wave, lane); rows_to_bf16_rs(in.p[0], H16, RS, gw, NGW, lane); }
    SEAM(0);

    for (int L = 0; L < NLOOP; ++L) {
        const int pb = 1 + 9 * L, j = L >> 1;
        if (L & 1) {
            if (EN(0) && IN(pb)) { pg8::Gemm g{H16, (const bf16*)(ws + WS_W1), M, GM_PROJ, D}; pg8::StaticOrder S; S.init(M, GM_PROJ, G, bx);
                pg8::EpiBf16<1, true> E{BIG, GM_PROJ, NT_G1G, RS}; pg8::gemm_phase<pg8::EpiBf16<1, true>, pg8::StaticOrder, PG_ALIGN, PG_SP2>(lds + RING_OFF, g, S, E); if (DUP(0)) { __syncthreads(); pg8::gemm_phase<pg8::EpiBf16<1, true>, pg8::StaticOrder, PG_ALIGN, PG_SP2>(lds + RING_OFF, g, S, E); } }
            SEAM(pb);
            if (!DIS_GMLP && IN(pb + 1)) {
#if GMLP_NAIVE
                gmlp_naive_phase(BIG, in.p[7] + j * 2048, in.p[8] + j * 2048, (const float*)(ws + WS_WST), in.p[10] + j * GM_G * GM_C, A, lds, tid, G);
                if (DUP(6)) gmlp_naive_phase(BIG, in.p[7] + j * 2048, in.p[8] + j * 2048, (const float*)(ws + WS_WST), in.p[10] + j * GM_G * GM_C, A, lds, tid, G);
#else
                gmlp_mfma_phase(BIG, in.p[7] + j * 2048, in.p[8] + j * 2048, (const bf16*)(ws + WS_WSB), in.p[10] + j * GM_G * GM_C, A, lds, tid, G);
                if (DUP(6)) gmlp_mfma_phase(BIG, in.p[7] + j * 2048, in.p[8] + j * 2048, (const bf16*)(ws + WS_WSB), in.p[10] + j * GM_G * GM_C, A, lds, tid, G);
#endif
            }
            SEAM(pb + 1);
        } else {
            if (EN(1) && IN(pb)) { pg8::Gemm g{H16, (const bf16*)(ws + WS_W1), M, HG_PROJ, D}; pg8::StaticOrder S; S.init(M, HG_PROJ, G, bx);
                pg8::EpiBf16<0, true> E{BIG, HG_PROJ, NT_G1H, RS}; pg8::gemm_phase<pg8::EpiBf16<0, true>, pg8::StaticOrder, PG_ALIGN, PG_SP2>(lds + RING_OFF, g, S, E); if (DUP(1)) { __syncthreads(); pg8::gemm_phase<pg8::EpiBf16<0, true>, pg8::StaticOrder, PG_ALIGN, PG_SP2>(lds + RING_OFF, g, S, E); } }
            SEAM(pb);
            if (!DIS_HGRN && IN(pb + 1)) {
#if HGRN_NAIVE
                hgrn_naive_phase(BIG, in.p[3], j, in.p[4] + j * HG_K, A, lds, tid, G);
                if (DUP(7)) hgrn_naive_phase(BIG, in.p[3], j, in.p[4] + j * HG_K, A, lds, tid, G);
#else
                if (HG_BOTH) { hgrn_naive_phase(BIG, in.p[3], j, in.p[4] + j * HG_K, A, lds, tid, G); __syncthreads(); }
                hgrn_mfma_phase(BIG, in.p[3], j, in.p[4] + j * HG_K, A, lds, tid, G);
                if (DUP(7)) hgrn_mfma_phase(BIG, in.p[3], j, in.p[4] + j * HG_K, A, lds, tid, G);
#endif
            }
            SEAM(pb + 1);
        }
        if (EN(2) && IN(pb + 2)) { pg8::Gemm g{A, (const bf16*)(ws + WS_W2), M, D, D}; pg8::StaticOrder S; S.init(M, D, G, bx);
            pg8::EpiBf16<0> E{MO, D, 0, nullptr}; pg8::gemm_phase<pg8::EpiBf16<0>, pg8::StaticOrder, PG_ALIGN, PG_SP2>(lds + RING_OFF, g, S, E); if (DUP(2)) { __syncthreads(); pg8::gemm_phase<pg8::EpiBf16<0>, pg8::StaticOrder, PG_ALIGN, PG_SP2>(lds + RING_OFF, g, S, E); } }
        SEAM(pb + 2);
        if (!DIS_THIN && IN(pb + 3)) { if (L == 0) thin_phase<true, false, true>(in.p[0], MO, in.p[13] + L * D, nullptr, H16, RS, gw, NGW, lane);
            else thin_phase<false, false, true>(H16, MO, in.p[13] + L * D, nullptr, H16, RS, gw, NGW, lane); }
        SEAM(pb + 3);
        if (EN(3) && IN(pb + 4)) { pg8::Gemm g{H16, (const bf16*)(ws + WS_WGU), M, 2 * FF, D}; pg8::StaticOrder S; S.init(M, 2 * FF, G, bx);
            pg8::EpiSwiGLU E{BIG, FF, RS}; pg8::gemm_phase<pg8::EpiSwiGLU, pg8::StaticOrder, PG_ALIGN, PG_SP2>(lds + RING_OFF, g, S, E); if (DUP(10)) { __syncthreads(); pg8::gemm_phase<pg8::EpiSwiGLU, pg8::StaticOrder, PG_ALIGN, PG_SP2, true>(lds + RING_OFF, g, S, E); } if (DUP(3)) { __syncthreads(); pg8::gemm_phase<pg8::EpiSwiGLU, pg8::StaticOrder, PG_ALIGN, PG_SP2>(lds + RING_OFF, g, S, E); } }
        SEAM(pb + 4);
        if (EN(4) && IN(pb + 5)) { pg8::Gemm g{BIG, (const bf16*)(ws + WS_WD), M, D, FF}; pg8::StaticOrder S; S.init(M, D, G, bx);
            pg8::EpiBf16<0> E{MO, D, 0, nullptr}; pg8::gemm_phase<pg8::EpiBf16<0>, pg8::StaticOrder, PG_ALIGN, PG_SP2>(lds + RING_OFF, g, S, E); if (DUP(4)) { __syncthreads(); pg8::gemm_phase<pg8::EpiBf16<0>, pg8::StaticOrder, PG_ALIGN, PG_SP2>(lds + RING_OFF, g, S, E); } }
        SEAM(pb + 5);
        if (!DIS_THIN && IN(pb + 6)) thin_phase<false, false, false>(H16, MO, in.p[15] + L * D, nullptr, H16, nullptr, gw, NGW, lane);
        SEAM(pb + 6);
        if (IN(pb + 7)) {
            if (EN(5)) { pg8::Gemm g{(const bf16*)(ws + WS_PB), (const bf16*)(ws + WS_WPP), M, D, PLE}; pg8::StaticOrder S; S.init(M, D, G, bx);
              pg8::EpiBf16<0> E{MO, D, 0, nullptr}; pg8::gemm_phase<pg8::EpiBf16<0>, pg8::StaticOrder, PG_ALIGN, PG_SP2>(lds + RING_OFF, g, S, E); }
            __syncthreads();
            if (EN(6)) { pg8::Gemm g{H16, (const bf16*)(ws + WS_WPG), M, D, D}; pg8::StaticOrder S; S.init(M, D, G, bx);
              pg8::EpiGateMulBf16 E{MO, D}; pg8::gemm_phase<pg8::EpiGateMulBf16, pg8::StaticOrder, PG_ALIGN, PG_SP2>(lds + RING_OFF, g, S, E); }
            if (DUP(5)) { __syncthreads();
            if (EN(5)) { pg8::Gemm g{(const bf16*)(ws + WS_PB), (const bf16*)(ws + WS_WPP), M, D, PLE}; pg8::StaticOrder S; S.init(M, D, G, bx);
              pg8::EpiBf16<0> E{MO, D, 0, nullptr}; pg8::gemm_phase<pg8::EpiBf16<0>, pg8::StaticOrder, PG_ALIGN, PG_SP2>(lds + RING_OFF, g, S, E); }
            __syncthreads();
            if (EN(6)) { pg8::Gemm g{H16, (const bf16*)(ws + WS_WPG), M, D, D}; pg8::StaticOrder S; S.init(M, D, G, bx);
              pg8::EpiGateMulBf16 E{MO, D}; pg8::gemm_phase<pg8::EpiGateMulBf16, pg8::StaticOrder, PG_ALIGN, PG_SP2>(lds + RING_OFF, g, S, E); }
            }
        }
        SEAM(pb + 7);
        if (!DIS_THIN && IN(pb + 8)) {
            if (L + 1 < DEPTH) { thin_phase<false, false, true>(H16, MO, in.p[21] + L * D, nullptr, H16, RS, gw, NGW, lane); __syncthreads(); convert_layer(in, ws, L + 1, lds, gw, NGW, wave, lane); if (DUP(9)) { __syncthreads(); convert_layer(in, ws, L + 1, lds, gw, NGW, wave, lane); } }
            else thin_phase<false, true, false>(H16, MO, in.p[21] + L * D, nullptr, out, nullptr, gw, NGW, lane);
        }
        SEAM(pb + 8);
    }
#undef IN
#undef SEAM
}

extern "C" void kernel_launch(void* const* d_in, const int* in_sizes, int n_in, void* d_out, int out_size, void* d_ws, size_t ws_size, hipStream_t stream) {
    static int grid = 0;
    if (grid == 0) {
        if (n_in != 22 || out_size != M * D || ws_size < WS_END) { fprintf(stderr, "kernel_launch: unexpected shapes: n_in %d out %d ws %zu (need %zu)\n", n_in, out_size, ws_size, (size_t)WS_END); grid = -1; return; }
        int dev = 0, cus = 0, per_cu = 0;
        if (hipGetDevice(&dev) != hipSuccess || hipDeviceGetAttribute(&cus, hipDeviceAttributeMultiprocessorCount, dev) != hipSuccess) { grid = -1; return; }
        if (hipFuncSetAttribute((const void*)fwd, hipFuncAttributeMaxDynamicSharedMemorySize, LDS_BYTES) != hipSuccess) { fprintf(stderr, "kernel_launch: hipFuncSetAttribute failed\n"); grid = -1; return; }
        if (hipOccupancyMaxActiveBlocksPerMultiprocessor(&per_cu, (const void*)fwd, NWAVES * 64, LDS_BYTES) != hipSuccess || per_cu < 1) fprintf(stderr, "kernel_launch: occupancy query says %d\n", per_cu);
        (void)hipGetLastError();
        grid = cus;
    }
    if (grid < 0) return;
    (void)hipMemsetAsync((char*)d_ws + WS_CTL, 0, CTL_ZERO_BYTES, stream);
    Args a{};
    for (int i = 0; i < 22; ++i) a.in.p[i] = (const float*)d_in[i];
    a.out = (float*)d_out; a.ws = (unsigned char*)d_ws;
#if MK_ONE_LAUNCH
    a.ph_lo = 0; a.ph_hi = NPHASE;
    hipLaunchKernelGGL(fwd, dim3(grid), dim3(NWAVES * 64), LDS_BYTES, stream, a);
#else
    for (int p = 0; p < NPHASE; ++p) { a.ph_lo = p; a.ph_hi = p + 1; hipLaunchKernelGGL(fwd, dim3(grid), dim3(NWAVES * 64), LDS_BYTES, stream, a); }
#endif
}
```

```cpp
#include <hip/hip_runtime.h>
#include <cstdio>
#include <cstdint>
#ifndef PG_WGM
#define PG_WGM 4
#endif
namespace pg8 {
#define PG8_LAS __attribute__((address_space(3)))
typedef unsigned short bf16_t;
typedef short bf16x8 __attribute__((ext_vector_type(8)));
typedef float f32x4 __attribute__((ext_vector_type(4)));
typedef unsigned u32x4 __attribute__((ext_vector_type(4)));
constexpr int BM = 256, BK = 64, HALF = 128, HTB = HALF * BK * 2  , STAGE_BYTES = 8 * HTB, NXCD = 8, WGM = PG_WGM;

__host__ __device__ __forceinline__ int lds_byte(int r, int c) { const int st = (r >> 4) * 2 + (c >> 5), rr = r & 15, cc = c & 31, ob = rr * 64 + cc * 2; return st * 1024 + (ob ^ (((ob >> 9) & 1) << 5)); }
__host__ __device__ __forceinline__ void stage_rc(int b, int& R, int& C) { const int st = b / 1024, sb = b % 1024, swz = sb ^ (((sb >> 9) & 1) << 5); R = (st >> 1) * 16 + swz / 64; C = (st & 1) * 32 + (swz % 64) / 2; }
__host__ __device__ __forceinline__ int perm32(int rho) { const int n = rho >> 4, i = rho & 15; return 8 * (i >> 2) + 4 * n + (i & 3); }

struct Unit { int pm, pn; };
struct Gemm { const bf16_t* A; const bf16_t* Bt; int M, N, K; };

struct StaticOrder {
    int nM, nN, nwg, G, c;
    __host__ __device__ void init(int M, int N, int G_, int c_) { nM = M / BM; nN = N / BM; nwg = nM * nN; G = G_; c = c_; }
    __host__ __device__ bool next(int i, Unit& u) const {
        const long L = (long)i * G + c; if (L >= nwg) return false;
        int wgid = (int)L; { const int q = nwg / NXCD, r = nwg % NXCD, xcd = wgid % NXCD, off = wgid / NXCD; wgid = (xcd < r ? xcd * (q + 1) : r * (q + 1) + (xcd - r) * q) + off; }
        const int nig = WGM * nN, gid = wgid / nig, fm = gid * WGM, gsz = (nM - fm) < WGM ? (nM - fm) : WGM;
        u.pm = fm + ((wgid % nig) % gsz); u.pn = (wgid % nig) / gsz; return true;
    }
    __device__ __forceinline__ void a_ready(const Unit&) const {}
    __device__ __forceinline__ void done(const Unit&) const {}
};


__device__ __forceinline__ unsigned cvt_pk_bf16(float lo, float hi) { unsigned r; asm volatile("v_cvt_pk_bf16_f32 %0, %1, %2" : "=v"(r) : "v"(lo), "v"(hi)); return r; }
typedef float f32x2 __attribute__((ext_vector_type(2)));
#ifndef NT_STORE
#define NT_STORE 0
#endif
__device__ __forceinline__ f32x2 gelu_pk(f32x2 v) {
    const f32x2 av = __builtin_elementwise_abs(v), d = av * 0.2316418882f + 1.0f;
    f32x2 t; t.x = __builtin_amdgcn_rcpf(d.x); t.y = __builtin_amdgcn_rcpf(d.y);
    f32x2 q = t * 0.5307027145f + (-0.7265760135f); q = q * t + 0.7107068705f; q = q * t + (-0.142248368f); q = q * t + 0.127414796f; q = q * t;
    const f32x2 s = (v * v) * (-0.72134752044f);
    f32x2 e; e.x = __builtin_amdgcn_exp2f(s.x); e.y = __builtin_amdgcn_exp2f(s.y);
    const f32x2 m = v * (q * e), r = v - m;
    f32x2 o; o.x = v.x < 0.f ? m.x : r.x; o.y = v.y < 0.f ? m.y : r.y; return o;
}
__device__ __forceinline__ float sigmoid_f(float x) { return __builtin_amdgcn_rcpf(1.0f + __builtin_amdgcn_exp2f(-1.4426950408889634f * x)); }
__device__ __forceinline__ float silu_f(float x) { return x * sigmoid_f(x); }

__host__ __device__ __forceinline__ int rs_slot(int row) { const int pm = row >> 8, r = row & 255; return (((pm * 2 + ((r >> 6) & 1)) * 16 + (r & 15)) * 8) + ((r >> 7) * 4) + ((r >> 4) & 3); }
__device__ __forceinline__ float rs_get(const u32x4& w, int i) { const unsigned x = (i >> 1) == 0 ? w.x : (i >> 1) == 1 ? w.y : (i >> 1) == 2 ? w.z : w.w; const unsigned short h = (unsigned short)((i & 1) ? (x >> 16) : (x & 0xffffu)); return (float)__builtin_bit_cast(_Float16, h); }
struct EpiF32 {
    static constexpr bool PERM = false, AFTER_DRAIN = false, ROWSCALE = false;
    float* C; int ldc;
    __device__ __forceinline__ void operator()(const f32x4 (&acc)[2][2][4][2], const Unit& u, int wr, int wc, int fr, int fq) const {
        const int row0 = u.pm * BM + wr * 64 + fr, col0 = u.pn * BM + wc * 32 + 4 * fq;
#pragma unroll
        for (int ai = 0; ai < 2; ++ai)
#pragma unroll
            for (int m = 0; m < 4; ++m) { float* rowp = C + (size_t)(row0 + ai * HALF + m * 16) * ldc + col0;
#pragma unroll
                for (int bj = 0; bj < 2; ++bj)
#pragma unroll
                    for (int n = 0; n < 2; ++n) *(f32x4*)(rowp + bj * HALF + n * 16) = acc[ai][bj][m][n]; }
    }
};
struct EpiGateMul {
    static constexpr bool PERM = false, AFTER_DRAIN = false, ROWSCALE = false;
    float* C; int ldc;
    __device__ __forceinline__ void operator()(const f32x4 (&acc)[2][2][4][2], const Unit& u, int wr, int wc, int fr, int fq) const {
        const int row0 = u.pm * BM + wr * 64 + fr, col0 = u.pn * BM + wc * 32 + 4 * fq;
#pragma unroll
        for (int ai = 0; ai < 2; ++ai)
#pragma unroll
            for (int m = 0; m < 4; ++m) { float* rowp = C + (size_t)(row0 + ai * HALF + m * 16) * ldc + col0;
#pragma unroll
                for (int bj = 0; bj < 2; ++bj)
#pragma unroll
                    for (int n = 0; n < 2; ++n) { f32x4 e = *(const f32x4*)(rowp + bj * HALF + n * 16); const f32x4 a = acc[ai][bj][m][n];
                        e[0] *= sigmoid_f(a[0]); e[1] *= sigmoid_f(a[1]); e[2] *= sigmoid_f(a[2]); e[3] *= sigmoid_f(a[3]);
                        *(f32x4*)(rowp + bj * HALF + n * 16) = e; } }
    }
};
template <int ACT, bool RS = false> struct EpiBf16 {
    static constexpr bool PERM = true, AFTER_DRAIN = false, ROWSCALE = RS;
    bf16_t* O; int ldc; int nt; const float* rs;
    __device__ __forceinline__ void prefetch(u32x4& rsv, const Unit& u, int wr, int fr) const { rsv = *(const u32x4*)((const unsigned short*)rs + ((u.pm * 2 + wr) * 16 + fr) * 8); }
    __device__ __forceinline__ void operator()(const f32x4 (&acc)[2][2][4][2], const Unit& u, int wr, int wc, int fr, int fq) const { const u32x4 one = {0x3c003c00u, 0x3c003c00u, 0x3c003c00u, 0x3c003c00u}; (*this)(acc, u, wr, wc, fr, fq, one); }
    __device__ __forceinline__ void operator()(const f32x4 (&acc)[2][2][4][2], const Unit& u, int wr, int wc, int fr, int fq, const u32x4& rsv) const {
        const int row0 = u.pm * BM + wr * 64 + fr, col0 = u.pn * BM + wc * 32 + 8 * fq;
#pragma unroll
        for (int ai = 0; ai < 2; ++ai)
#pragma unroll
            for (int m = 0; m < 4; ++m) { bf16_t* rowp = O + (size_t)(row0 + ai * HALF + m * 16) * ldc + col0; const float sc = rs_get(rsv, ai * 4 + m);
#pragma unroll
                for (int bj = 0; bj < 2; ++bj) { f32x4 v0 = acc[ai][bj][m][0], v1 = acc[ai][bj][m][1];
                    if (RS) { v0 = v0 * sc; v1 = v1 * sc; }
                    if (ACT == 1) { f32x2 a = gelu_pk((f32x2){v0[0], v0[1]}), b = gelu_pk((f32x2){v0[2], v0[3]}), c = gelu_pk((f32x2){v1[0], v1[1]}), d = gelu_pk((f32x2){v1[2], v1[3]});
                        v0 = (f32x4){a.x, a.y, b.x, b.y}; v1 = (f32x4){c.x, c.y, d.x, d.y}; }
                    u32x4 w; w.x = cvt_pk_bf16(v0[0], v0[1]); w.y = cvt_pk_bf16(v0[2], v0[3]); w.z = cvt_pk_bf16(v1[0], v1[1]); w.w = cvt_pk_bf16(v1[2], v1[3]);
                    if (nt) __builtin_nontemporal_store(w, (u32x4*)(rowp + bj * HALF)); else *(u32x4*)(rowp + bj * HALF) = w; } }
    }
};

struct EpiGateMulBf16 {
    static constexpr bool PERM = true, AFTER_DRAIN = false, ROWSCALE = false;
    bf16_t* O; int ldc;
    __device__ __forceinline__ void operator()(const f32x4 (&acc)[2][2][4][2], const Unit& u, int wr, int wc, int fr, int fq) const {
        const int row0 = u.pm * BM + wr * 64 + fr, col0 = u.pn * BM + wc * 32 + 8 * fq;
#pragma unroll
        for (int ai = 0; ai < 2; ++ai)
#pragma unroll
            for (int m = 0; m < 4; ++m) { bf16_t* rowp = O + (size_t)(row0 + ai * HALF + m * 16) * ldc + col0;
#pragma unroll
                for (int bj = 0; bj < 2; ++bj) { const u32x4 ev = *(const u32x4*)(rowp + bj * HALF); const f32x4 v0 = acc[ai][bj][m][0], v1 = acc[ai][bj][m][1];
                    const unsigned e0 = ev.x, e1 = ev.y, e2 = ev.z, e3 = ev.w;
                    u32x4 w;
                    w.x = cvt_pk_bf16(__builtin_bit_cast(float, e0 << 16) * sigmoid_f(v0[0]), __builtin_bit_cast(float, e0 & 0xffff0000u) * sigmoid_f(v0[1]));
                    w.y = cvt_pk_bf16(__builtin_bit_cast(float, e1 << 16) * sigmoid_f(v0[2]), __builtin_bit_cast(float, e1 & 0xffff0000u) * sigmoid_f(v0[3]));
                    w.z = cvt_pk_bf16(__builtin_bit_cast(float, e2 << 16) * sigmoid_f(v1[0]), __builtin_bit_cast(float, e2 & 0xffff0000u) * sigmoid_f(v1[1]));
                    w.w = cvt_pk_bf16(__builtin_bit_cast(float, e3 << 16) * sigmoid_f(v1[2]), __builtin_bit_cast(float, e3 & 0xffff0000u) * sigmoid_f(v1[3]));
                    *(u32x4*)(rowp + bj * HALF) = w; } }
    }
};
struct EpiSwiGLU {
    static constexpr bool PERM = true, AFTER_DRAIN = false, ROWSCALE = true;
    bf16_t* O; int ldc; const float* rs;
    __device__ __forceinline__ void prefetch(u32x4& rsv, const Unit& u, int wr, int fr) const { rsv = *(const u32x4*)((const unsigned short*)rs + ((u.pm * 2 + wr) * 16 + fr) * 8); }
    __device__ __forceinline__ void operator()(const f32x4 (&acc)[2][2][4][2], const Unit& u, int wr, int wc, int fr, int fq, const u32x4& rsv) const {
        const int row0 = u.pm * BM + wr * 64 + fr, col0 = u.pn * HALF + wc * 32 + 8 * fq;
#pragma unroll
        for (int ai = 0; ai < 2; ++ai)
#pragma unroll
            for (int m = 0; m < 4; ++m) { bf16_t* rowp = O + (size_t)(row0 + ai * HALF + m * 16) * ldc + col0; const float sc = rs_get(rsv, ai * 4 + m);
                const f32x4 g0 = acc[ai][0][m][0] * sc, g1 = acc[ai][0][m][1] * sc, u0 = acc[ai][1][m][0] * sc, u1 = acc[ai][1][m][1] * sc;
                u32x4 w; w.x = cvt_pk_bf16(silu_f(g0[0]) * u0[0], silu_f(g0[1]) * u0[1]); w.y = cvt_pk_bf16(silu_f(g0[2]) * u0[2], silu_f(g0[3]) * u0[3]);
                w.z = cvt_pk_bf16(silu_f(g1[0]) * u1[0], silu_f(g1[1]) * u1[1]); w.w = cvt_pk_bf16(silu_f(g1[2]) * u1[2], silu_f(g1[3]) * u1[3]);
                *(u32x4*)rowp = w; }
    }
};

template <class Epi, class Sched, bool ALIGN_EPI = false, bool SP2 = false, bool NOEPI = false>
__device__ __forceinline__ void gemm_phase(PG8_LAS unsigned char* lds, const Gemm g, const Sched& S, const Epi& E) {
    int tid_ = threadIdx.x; asm volatile("" : "+v"(tid_));
    const int tid = tid_, wid = __builtin_amdgcn_readfirstlane(tid >> 6), lane = tid & 63, wr = wid >> 2, wc = wid & 3, fr = lane & 15, fq = lane >> 4;
    const int K = g.K, nt = K / BK;
    unsigned voffA[2], voffB[2];
#pragma unroll
    for (int i = 0; i < 2; ++i) { int R, C; stage_rc(tid * 16 + i * 8192, R, C); const int Rb = Epi::PERM ? ((R & ~31) + perm32(R & 31)) : R;
        voffA[i] = (unsigned)(R * K + C) * 2u; voffB[i] = (unsigned)(Rb * K + C) * 2u; }
    const size_t kstep = (size_t)(BK * 2);
    const size_t hstep = (size_t)HALF * K * 2;
    const size_t tstep = 2 * hstep;
    const unsigned ldsw = (unsigned)wid * 1024u;
    const int aoff = lds_byte(wr * 64 + fr, fq * 8), boff = lds_byte(wc * 32 + fr, fq * 8);
#define PG8_SA(b, h) (((b) * 2 + (h)) * HTB)
#define PG8_SB(b, h) ((4 + (b) * 2 + (h)) * HTB)
#define PG8_STAGE(bufoff, gbase, voff) do { _Pragma("unroll") for (int _i = 0; _i < 2; ++_i) \
        __builtin_amdgcn_global_load_lds((const unsigned*)((const char*)(gbase) + (voff)[_i]), (PG8_LAS unsigned*)(lds + (bufoff) + ldsw + _i * 8192), 16, 0, 0); } while (0)
#define PG8_LDA(dst, b, h) do { _Pragma("unroll") for (int m = 0; m < 4; ++m) _Pragma("unroll") for (int k = 0; k < 2; ++k) dst[m][k] = *(const PG8_LAS bf16x8*)(lds + PG8_SA(b, h) + aoff + m * 2048 + k * 1024); } while (0)
#define PG8_LDB(dst, b, h) do { _Pragma("unroll") for (int n = 0; n < 2; ++n) _Pragma("unroll") for (int k = 0; k < 2; ++k) dst[n][k] = *(const PG8_LAS bf16x8*)(lds + PG8_SB(b, h) + boff + n * 2048 + k * 1024); } while (0)
#define PG8_MMA(ai, bj, At, Bt) do { __builtin_amdgcn_s_setprio(1); _Pragma("unroll") for (int m = 0; m < 4; ++m) _Pragma("unroll") for (int n = 0; n < 2; ++n) _Pragma("unroll") for (int k = 0; k < 2; ++k) \
        acc[ai][bj][m][n] = __builtin_amdgcn_mfma_f32_16x16x32_bf16(Bt[n][k], At[m][k], acc[ai][bj][m][n], 0, 0, 0); __builtin_amdgcn_s_setprio(0); } while (0)
#define PG8_WAIT_V(n) asm volatile("s_waitcnt vmcnt(" #n ")" ::: "memory")
#define PG8_WAIT_L(n) asm volatile("s_waitcnt lgkmcnt(" #n ")" ::: "memory")
#define PG8_BAR __builtin_amdgcn_s_barrier()
#define PG8_SCHED __builtin_amdgcn_sched_barrier(0)
    Unit cur, nxt; int ui = 0;
    if (!S.next(0, cur)) return;
    f32x4 acc[2][2][4][2];
#pragma unroll
    for (int a = 0; a < 2; ++a)
#pragma unroll
        for (int b = 0; b < 2; ++b)
#pragma unroll
            for (int m = 0; m < 4; ++m)
#pragma unroll
                for (int n = 0; n < 2; ++n) acc[a][b][m][n] = (f32x4){0.f, 0.f, 0.f, 0.f};
    bf16x8 At[4][2], B0[2][2], B1[2][2];
    u32x4 rsv;
    const char* cA = (const char*)g.A + (size_t)cur.pm * tstep; const char* cB = (const char*)g.Bt + (size_t)cur.pn * tstep;
    S.a_ready(cur);
    if constexpr (SP2) {
        PG8_STAGE(PG8_SB(0, 0), cB, voffB); PG8_STAGE(PG8_SB(0, 1), cB + hstep, voffB); PG8_STAGE(PG8_SA(0, 0), cA, voffA); PG8_STAGE(PG8_SA(0, 1), cA + hstep, voffA);
        if (wr == 1) PG8_BAR;
        PG8_WAIT_V(2); PG8_BAR;
        PG8_STAGE(PG8_SB(1, 0), cB + kstep, voffB); PG8_STAGE(PG8_SA(1, 0), cA + kstep, voffA); PG8_STAGE(PG8_SB(1, 1), cB + hstep + kstep, voffB);
        PG8_WAIT_V(6); PG8_BAR;
    } else {
        PG8_STAGE(PG8_SB(0, 0), cB, voffB); PG8_STAGE(PG8_SA(0, 0), cA, voffA); PG8_STAGE(PG8_SB(0, 1), cB + hstep, voffB); PG8_STAGE(PG8_SA(0, 1), cA + hstep, voffA);
        if (wr == 1) PG8_BAR;
        PG8_WAIT_V(4); PG8_BAR;
        PG8_STAGE(PG8_SB(1, 0), cB + kstep, voffB); PG8_STAGE(PG8_SA(1, 0), cA + kstep, voffA); PG8_STAGE(PG8_SB(1, 1), cB + hstep + kstep, voffB);
        PG8_WAIT_V(6); PG8_BAR;
    }
    for (;;) {
        const bool has_next = S.next(ui + 1, nxt);
        const char* nA = has_next ? (const char*)g.A + (size_t)nxt.pm * tstep : cA; const char* nB = has_next ? (const char*)g.Bt + (size_t)nxt.pn * tstep : cB;
        for (int t = 0; t < nt; t += 2) {
            const bool last = (t == nt - 2);
            const char* a1 = cA + (size_t)(t + 1) * kstep;
            const char* a2 = last ? nA : cA + (size_t)(t + 2) * kstep; const char* b2 = last ? nB : cB + (size_t)(t + 2) * kstep;
            const char* a3 = a2 + kstep; const char* b3 = b2 + kstep;
            if (last && has_next) S.a_ready(nxt);
            if constexpr (Epi::ROWSCALE) { if (last) E.prefetch(rsv, cur, wr, fr); }
            if constexpr (SP2) {
            PG8_LDB(B0, 0, 0); PG8_LDB(B1, 0, 1); PG8_SCHED; PG8_LDA(At, 0, 0); PG8_STAGE(PG8_SA(1, 1), a1 + hstep, voffA);
            PG8_WAIT_V(8); PG8_WAIT_L(0); PG8_BAR; PG8_MMA(0, 0, At, B0); PG8_MMA(0, 1, At, B1); PG8_BAR; PG8_SCHED;
            PG8_LDA(At, 0, 1); PG8_STAGE(PG8_SB(0, 0), b2, voffB); PG8_STAGE(PG8_SB(0, 1), b2 + hstep, voffB); PG8_STAGE(PG8_SA(0, 0), a2, voffA);
            PG8_WAIT_V(8); PG8_WAIT_L(0); PG8_BAR; PG8_MMA(1, 0, At, B0); PG8_MMA(1, 1, At, B1); PG8_BAR; PG8_SCHED;
            PG8_LDB(B0, 1, 0); PG8_LDB(B1, 1, 1); PG8_SCHED; PG8_LDA(At, 1, 0); PG8_STAGE(PG8_SA(0, 1), a2 + hstep, voffA);
            PG8_WAIT_V(8); PG8_WAIT_L(0); PG8_BAR; PG8_MMA(0, 0, At, B0); PG8_MMA(0, 1, At, B1); PG8_BAR; PG8_SCHED;
            PG8_LDA(At, 1, 1); PG8_STAGE(PG8_SB(1, 0), b3, voffB); PG8_STAGE(PG8_SB(1, 1), b3 + hstep, voffB); PG8_STAGE(PG8_SA(1, 0), a3, voffA);
            PG8_WAIT_V(8); PG8_WAIT_L(0); PG8_BAR; PG8_MMA(1, 0, At, B0); PG8_MMA(1, 1, At, B1); PG8_BAR; PG8_SCHED;
            } else {
            PG8_LDB(B0, 0, 0); PG8_SCHED; PG8_LDA(At, 0, 0); PG8_STAGE(PG8_SA(1, 1), a1 + hstep, voffA);
            PG8_WAIT_L(8); PG8_BAR; PG8_WAIT_L(0); PG8_MMA(0, 0, At, B0); PG8_BAR; PG8_SCHED;
            PG8_LDB(B1, 0, 1); PG8_STAGE(PG8_SB(0, 0), b2, voffB);
            PG8_BAR; PG8_WAIT_L(0); PG8_MMA(0, 1, At, B1); PG8_BAR;
            PG8_LDA(At, 0, 1); PG8_STAGE(PG8_SA(0, 0), a2, voffA);
            PG8_BAR; PG8_WAIT_L(0); PG8_MMA(1, 0, At, B0); PG8_BAR; PG8_SCHED;
            PG8_STAGE(PG8_SB(0, 1), b2 + hstep, voffB);
            PG8_WAIT_V(6); PG8_BAR; PG8_MMA(1, 1, At, B1); PG8_BAR;
            PG8_LDB(B0, 1, 0); PG8_SCHED; PG8_LDA(At, 1, 0); PG8_STAGE(PG8_SA(0, 1), a2 + hstep, voffA);
            PG8_WAIT_L(8); PG8_BAR; PG8_WAIT_L(0); PG8_MMA(0, 0, At, B0); PG8_BAR; PG8_SCHED;
            PG8_LDB(B1, 1, 1); PG8_STAGE(PG8_SB(1, 0), b3, voffB);
            PG8_BAR; PG8_WAIT_L(0); PG8_MMA(0, 1, At, B1); PG8_BAR;
            PG8_LDA(At, 1, 1); PG8_STAGE(PG8_SA(1, 0), a3, voffA);
            PG8_BAR; PG8_WAIT_L(0); PG8_MMA(1, 0, At, B0); PG8_BAR; PG8_SCHED;
            PG8_STAGE(PG8_SB(1, 1), b3 + hstep, voffB);
            PG8_WAIT_V(6); PG8_BAR; PG8_MMA(1, 1, At, B1); PG8_BAR;
            }
        }
        if constexpr (ALIGN_EPI) { if (wr == 0) PG8_BAR; }
        if constexpr (!Epi::AFTER_DRAIN && !NOEPI) { if constexpr (Epi::ROWSCALE) E(acc, cur, wr, wc, fr, fq, rsv); else E(acc, cur, wr, wc, fr, fq); S.done(cur); }
        if constexpr (NOEPI) { f32x4 sacc = (f32x4){0.f, 0.f, 0.f, 0.f};
#pragma unroll
            for (int a = 0; a < 2; ++a)
#pragma unroll
                for (int bb = 0; bb < 2; ++bb)
#pragma unroll
                    for (int m = 0; m < 4; ++m)
#pragma unroll
                        for (int n = 0; n < 2; ++n) sacc += acc[a][bb][m][n];
            asm volatile("" :: "v"(sacc)); }
        if (!has_next) break;
#pragma unroll
        for (int a = 0; a < 2; ++a)
#pragma unroll
            for (int b = 0; b < 2; ++b)
#pragma unroll
                for (int m = 0; m < 4; ++m)
#pragma unroll
                    for (int n = 0; n < 2; ++n) acc[a][b][m][n] = (f32x4){0.f, 0.f, 0.f, 0.f};
        cur = nxt; cA = nA; cB = nB; ++ui;
        if constexpr (ALIGN_EPI) { if (wr == 1) PG8_BAR; }
    }
    PG8_WAIT_V(0);
    if constexpr (!ALIGN_EPI) { if (wr == 0) PG8_BAR; }
    PG8_BAR;
    if constexpr (Epi::AFTER_DRAIN) { E.fused(acc, cur, wr, wc, fr, fq, lds, wid, lane); S.done(cur); }
#undef PG8_SA
#undef PG8_SB
#undef PG8_STAGE
#undef PG8_LDA
#undef PG8_LDB
#undef PG8_MMA
#undef PG8_WAIT_V
#undef PG8_WAIT_L
#undef PG8_BAR
#undef PG8_SCHED
}
}
#define GAS __attribute__((address_space(1)))
#define LAS __attribute__((address_space(3)))
typedef unsigned short bf16;
typedef unsigned v4u __attribute__((ext_vector_type(4)));
typedef float f32x4 __attribute__((ext_vector_type(4)));
typedef short bf16x8 __attribute__((ext_vector_type(8)));
typedef GAS unsigned gu32;
typedef GAS unsigned long long gu64;
#define RLX_AGENT __ATOMIC_RELAXED, __HIP_MEMORY_SCOPE_AGENT
#define LDS_WAIT() asm volatile("s_waitcnt lgkmcnt(0)" ::: "memory")
#define VM_WAIT() asm volatile("s_waitcnt vmcnt(0)" ::: "memory")
__device__ __forceinline__ unsigned long long rt() { return __builtin_amdgcn_s_memrealtime(); }
__device__ __forceinline__ unsigned f2bf(float f) { unsigned u = __builtin_bit_cast(unsigned, f); return (u + 0x7fffu + ((u >> 16) & 1u)) >> 16; }
__device__ __forceinline__ unsigned pk2(float lo, float hi) { return f2bf(lo) | (f2bf(hi) << 16); }

#define XB_TMO      128
#define XB_XCNT(j)  (256  + 64 * (j))
#define XB_XSUB(j)  (1280 + 64 * (j))
#define XB_XGEN(j)  (2304 + 64 * (j))
#define XB_TOP      3328
#define XB_TOPGEN   3392
#define XCD_BAR_WORDS 3456
#define XB_SPIN_CAP (1u << 18)

__device__ __forceinline__ unsigned xb_ld(unsigned* p)              { return __hip_atomic_load(p, __ATOMIC_RELAXED, __HIP_MEMORY_SCOPE_AGENT); }
__device__ __forceinline__ unsigned xb_add(unsigned* p, unsigned v) { return __hip_atomic_fetch_add(p, v, __ATOMIC_RELAXED, __HIP_MEMORY_SCOPE_AGENT); }
__device__ __forceinline__ unsigned xb_xcc_id() { return (unsigned)__builtin_amdgcn_s_getreg((3 << 11) | 20) & 0xFu; }
#define XB_SPIN(cond, bar) do { unsigned _sp = 0; while (cond) { __builtin_amdgcn_s_sleep(1); \
    if ((++_sp & 255u) == 0u) { if (xb_ld(&(bar)[XB_TMO])) break; if (_sp > XB_SPIN_CAP) { atomicAdd(&(bar)[XB_TMO], 1u); break; } } } } while (0)

struct XcdBarrier {
    unsigned* bar; unsigned x;
    volatile LAS unsigned* st;
};

__device__ __forceinline__ XcdBarrier xcd_barrier_post(unsigned* bar, volatile LAS unsigned* st) {
    XcdBarrier b; b.bar = bar; b.x = xb_xcc_id(); b.st = st;
    if (threadIdx.x == 0) (void)xb_add(&bar[XB_XCNT(b.x)], 1u);
    return b;
}
__device__ __forceinline__ void xcd_barrier_complete(unsigned* bar, unsigned x, unsigned& nloc, unsigned& nx) {
    const unsigned G = gridDim.x * gridDim.y * gridDim.z;
    unsigned sum, cnt, mine, sp = 0u;
    for (;;) {
        sum = 0u; cnt = 0u; mine = 0u;
#pragma unroll
        for (unsigned j = 0; j < 16; ++j) { const unsigned c = xb_ld(&bar[XB_XCNT(j)]); sum += c; cnt += (c > 0u) ? 1u : 0u; mine = (j == x) ? c : mine; }
        if (sum == G) break;
        __builtin_amdgcn_s_sleep(1);
        if ((++sp & 255u) == 0u) { if (xb_ld(&bar[XB_TMO])) break; if (sp > XB_SPIN_CAP) { atomicAdd(&bar[XB_TMO], 1u); break; } }
    }
    nloc = mine > 0u ? mine : 1u; nx = cnt > 0u ? cnt : 1u;
}

__device__ __forceinline__ void xcd_barrier(const XcdBarrier& b) {
    asm volatile("s_waitcnt vmcnt(0)" ::: "memory");
    __syncthreads();
    if (threadIdx.x == 0) {
        unsigned* bar = b.bar;
        __builtin_amdgcn_s_waitcnt(0);
        unsigned nloc = b.st[0], nx = b.st[1];
        if (nloc == 0u) { xcd_barrier_complete(bar, b.x, nloc, nx); b.st[0] = nloc; b.st[1] = nx; }
        const unsigned old = xb_add(&bar[XB_XSUB(b.x)], 1u);
        const unsigned gen = old / nloc;
        if (old + 1u == (gen + 1u) * nloc) {
            __builtin_amdgcn_fence(__ATOMIC_RELEASE, "agent");
            asm volatile("s_waitcnt vmcnt(0)" ::: "memory");
            const unsigned og = xb_add(&bar[XB_TOP], 1u);
            const unsigned tg = og / nx;
            if (og + 1u == (tg + 1u) * nx) xb_add(&bar[XB_TOPGEN], 1u);
            else XB_SPIN(xb_ld(&bar[XB_TOPGEN]) == tg, bar);
            __builtin_amdgcn_fence(__ATOMIC_ACQUIRE, "agent");
            xb_add(&bar[XB_XGEN(b.x)], 1u);
            asm volatile("s_waitcnt vmcnt(0)" ::: "memory");
        } else {
            XB_SPIN(xb_ld(&bar[XB_XGEN(b.x)]) == gen, bar);
            __builtin_amdgcn_fence(__ATOMIC_ACQUIRE, "agent");
            asm volatile("s_waitcnt vmcnt(0)" ::: "memory");
        }
    }
    __syncthreads();
}


constexpr int NWAVES = 8;
constexpr int BATCH = 16, SEQ = 2048, D = 2048, DEPTH = 4, M = BATCH * SEQ;
constexpr int HG_PROJ = 8192, HG_HEADS = 16, HG_K = 128;
constexpr int GM_PROJ = 4096, GM_G = 16, GM_C = 128;
constexpr int FF = 5632, PLE = 256;
constexpr float EPS = 1e-6f;
constexpr int NPHASE = 1 + 9 * DEPTH;

#ifndef DIS_GMLP
#define DIS_GMLP 0
#endif
#ifndef DIS_HGRN
#define DIS_HGRN 0
#endif
#ifndef DIS_THIN
#define DIS_THIN 0
#endif
#ifndef NLOOP
#define NLOOP DEPTH
#endif
#ifndef DUP_MASK
#define DUP_MASK 0
#endif
#define DUP(n) (((DUP_MASK) >> (n)) & 1)
#ifndef HG_FILTER
#define HG_FILTER(t0, t) true
#endif
#ifndef HG_BOTH
#define HG_BOTH 0
#endif
#ifndef PG_ALIGN
#define PG_ALIGN true
#endif
#ifndef PG_SP2
#define PG_SP2 true
#endif
#ifndef THIN_NT
#define THIN_NT 1
#endif
#ifndef NT_G1H
#define NT_G1H 0
#endif
#ifndef NT_G1G
#define NT_G1G 0
#endif
#ifndef GMLP_NAIVE
#define GMLP_NAIVE 0
#endif
#ifndef HGRN_NAIVE
#define HGRN_NAIVE 0
#endif
#ifndef EN_MASK
#define EN_MASK 0xff
#endif
#define EN(n) (((EN_MASK) >> (n)) & 1)
#ifndef MK_ONE_LAUNCH
#define MK_ONE_LAUNCH 1
#endif

constexpr size_t MiB = 1u << 20;
constexpr size_t WS_CTL = 0, CTL_ZERO_BYTES = 65536;
constexpr size_t WS_W1 = 1 * MiB;
constexpr size_t WS_W2 = 33 * MiB;
constexpr size_t WS_WGU = 41 * MiB;
constexpr size_t WS_WD = 85 * MiB;
constexpr size_t WS_WPG = 107 * MiB;
constexpr size_t WS_WPP = 115 * MiB;
constexpr size_t WS_PB = 116 * MiB;
constexpr size_t WS_WST = 132 * MiB;
constexpr size_t WS_WSB = 133 * MiB;
constexpr size_t WS_RS = 133 * MiB + 512 * 1024;
constexpr size_t WS_A = 134 * MiB;
constexpr size_t WS_BIG = 262 * MiB;
constexpr size_t WS_MO = 774 * MiB;
constexpr size_t WS_END = 1030 * MiB;
constexpr int CW_BAR = 4096;

constexpr int RING_OFF = 0, RING_BYTES = 131072;
constexpr int LDSCTL_OFF = RING_BYTES, MISC_OFF = LDSCTL_OFF + 320, XTRA_OFF = LDSCTL_OFF + 1024;
constexpr int LDS_BYTES = 147456;

typedef unsigned v2u __attribute__((ext_vector_type(2)));
#if LBAR_SYNC
#define LBAR() __syncthreads()
#else
#define LBAR() do { asm volatile("s_waitcnt lgkmcnt(0)" ::: "memory"); __builtin_amdgcn_s_barrier(); asm volatile("" ::: "memory"); } while (0)
#endif
__device__ __forceinline__ float wave_sum(float v) {
#pragma unroll
    for (int o = 1; o < 64; o <<= 1) v += __shfl_xor(v, o);
    return v;
}
__device__ __forceinline__ float dot4(f32x4 a) { return (a.x * a.x + a.y * a.y) + (a.z * a.z + a.w * a.w); }
__device__ __forceinline__ float bf2f(unsigned short b) { return __builtin_bit_cast(float, ((unsigned)b) << 16); }
__device__ __forceinline__ float bfw(unsigned w, int hi) { return __builtin_bit_cast(float, hi ? (w & 0xffff0000u) : (w << 16)); }
__device__ __forceinline__ float sigm(float x) { return 1.0f / (1.0f + __expf(-x)); }

struct TItem { const float* W; bf16* WT; int K, N, mode, item; const float* ks; };
__device__ __forceinline__ void titem_load(const TItem& t, float (&v)[32], int lane) {
    const int nblk = t.N / 32, kb = t.item / nblk, nb = t.item % nblk, k0 = 64 * kb, n0 = 32 * nb;
    const float* src = t.W + (size_t)(k0 + (lane >> 5)) * t.N + n0 + (lane & 31);
#pragma unroll
    for (int i = 0; i < 32; ++i) v[i] = *(const GAS float*)(src + (size_t)(2 * i) * t.N);
}
__device__ __forceinline__ void titem_finish(const TItem& t, const float (&v)[32], LAS float* scr, int lane) {
    const int nblk = t.N / 32, kb = t.item / nblk, nb = t.item % nblk, k0 = 64 * kb, n0 = 32 * nb;
    const int d0 = t.mode == 0 ? n0 : ((n0 >> 7) * 256 + (n0 & 127) + (t.mode == 2 ? 128 : 0));
#pragma unroll
    for (int i = 0; i < 32; ++i) scr[(2 * i + (lane >> 5)) * 33 + (lane & 31)] = v[i];
    LDS_WAIT(); asm volatile("" ::: "memory");
    const int c = lane & 7;
    f32x4 ks0 = (f32x4){1.f, 1.f, 1.f, 1.f}, ks1 = ks0;
    if (t.ks) { ks0 = *(const GAS f32x4*)(t.ks + k0 + 8 * c); ks1 = *(const GAS f32x4*)(t.ks + k0 + 8 * c + 4); }
#pragma unroll
    for (int j = 0; j < 4; ++j) { const int n = (lane >> 3) + 8 * j; const LAS float* s = scr + (8 * c) * 33 + n;
        v4u o; o.x = pk2(s[0 * 33] * ks0.x, s[1 * 33] * ks0.y); o.y = pk2(s[2 * 33] * ks0.z, s[3 * 33] * ks0.w); o.z = pk2(s[4 * 33] * ks1.x, s[5 * 33] * ks1.y); o.w = pk2(s[6 * 33] * ks1.z, s[7 * 33] * ks1.w);
        *(GAS v4u*)(t.WT + (size_t)(d0 + n) * t.K + k0 + 8 * c) = o; }
    LDS_WAIT(); asm volatile("" ::: "memory");
}

struct In { const float* p[22]; };

__device__ __forceinline__ void convert_layer(const In& in, unsigned char* ws, int L, LAS unsigned char* lds, int gw, int NGW, int wave, int lane) {
    asm volatile("" : "+v"(lane));
    LAS float* scr = (LAS float*)(lds + RING_OFF + wave * 16384);
    const int j = L >> 1;
    const bool odd = (L & 1) != 0;
    const float* w1 = odd ? in.p[6] + (size_t)j * D * GM_PROJ : in.p[2] + (size_t)j * D * HG_PROJ;
    const int n1 = odd ? GM_PROJ : HG_PROJ;
    const float* w2 = odd ? in.p[11] + (size_t)j * D * D : in.p[5] + (size_t)j * D * D;
    const float* wg = in.p[16] + (size_t)L * D * FF; const float* wu = in.p[17] + (size_t)L * D * FF; const float* wd = in.p[18] + (size_t)L * FF * D;
    const float* wpp = in.p[19] + (size_t)L * PLE * D; const float* wpg = in.p[20] + (size_t)L * D * D;
    const int I1 = (D / 64) * (n1 / 32), I2 = (D / 64) * (D / 32), IG = (D / 64) * (FF / 32), ID = (FF / 64) * (D / 32), IPP = (PLE / 64) * (D / 32);
    const int NITEMS = I1 + I2 + 2 * IG + ID + I2 + IPP;
#define CV_ITEM(t, it_) do { int r = (it_); \
        if (r < I1) { t = TItem{w1, (bf16*)(ws + WS_W1), D, n1, 0, r, in.p[12] + L * D}; break; } r -= I1; \
        if (r < I2) { t = TItem{w2, (bf16*)(ws + WS_W2), D, D, 0, r, nullptr}; break; } r -= I2; \
        if (r < IG) { t = TItem{wg, (bf16*)(ws + WS_WGU), D, FF, 1, r, in.p[14] + L * D}; break; } r -= IG; \
        if (r < IG) { t = TItem{wu, (bf16*)(ws + WS_WGU), D, FF, 2, r, in.p[14] + L * D}; break; } r -= IG; \
        if (r < ID) { t = TItem{wd, (bf16*)(ws + WS_WD), FF, D, 0, r, nullptr}; break; } r -= ID; \
        if (r < I2) { t = TItem{wpg, (bf16*)(ws + WS_WPG), D, D, 0, r, nullptr}; break; } r -= I2; \
        t = TItem{wpp, (bf16*)(ws + WS_WPP), PLE, D, 0, r, nullptr}; } while (0)
    for (int it = gw; it < NITEMS; it += 2 * NGW) {
        TItem t0, t1; float v0[32], v1[32]; const bool has1 = (it + NGW < NITEMS);
        CV_ITEM(t0, it); titem_load(t0, v0, lane);
        if (has1) { CV_ITEM(t1, it + NGW); titem_load(t1, v1, lane); }
        titem_finish(t0, v0, scr, lane);
        if (has1) titem_finish(t1, v1, scr, lane);
    }
#undef CV_ITEM
    { const float* ps = in.p[1] + (size_t)L * M * PLE; bf16* pb = (bf16*)(ws + WS_PB);
      for (size_t i = (size_t)gw * 64 + lane; i < (size_t)M * PLE / 8; i += (size_t)NGW * 64) {
          const f32x4 a = *(const GAS f32x4*)(ps + i * 8), b = *(const GAS f32x4*)(ps + i * 8 + 4);
          v4u o; o.x = pk2(a.x, a.y); o.y = pk2(a.z, a.w); o.z = pk2(b.x, b.y); o.w = pk2(b.z, b.w);
          *(GAS v4u*)(pb + i * 8) = o; } }
    if (odd) {
        const float* wsrc = in.p[9] + (size_t)j * GM_G * GM_C * GM_C; float* wst = (float*)(ws + WS_WST);
        for (int i = gw * 64 + lane; i < GM_G * GM_C * GM_C; i += NGW * 64) { const int t = i & 127, s = (i >> 7) & 127, g = i >> 14;
            wst[i] = (s <= t) ? wsrc[(g * GM_C + t) * GM_C + s] : 0.f; }
        bf16* wsb = (bf16*)(ws + WS_WSB);
        for (int i = gw * 64 + lane; i < GM_G * GM_C * GM_C; i += NGW * 64) { const int s2 = i & 127, t2 = (i >> 7) & 127; wsb[i] = (bf16)((s2 <= t2) ? f2bf(wsrc[i]) : 0u); }
    }
}

__device__ __forceinline__ void rows_to_bf16_rs(const float* x, bf16* H, float* rs, int gw, int NGW, int lane) {
    for (int m = gw; m < M; m += NGW) {
        const GAS f32x4* xr = (const GAS f32x4*)(x + (size_t)m * D) + 2 * lane;
        f32x4 v[8]; float ss = 0.f;
#pragma unroll
        for (int j = 0; j < 4; ++j) { v[2 * j] = xr[128 * j]; v[2 * j + 1] = xr[128 * j + 1]; ss += dot4(v[2 * j]) + dot4(v[2 * j + 1]); }
        const float rstd = __builtin_amdgcn_rsqf(wave_sum(ss) * (1.f / D) + EPS);
        GAS v4u* o16 = (GAS v4u*)(H + (size_t)m * D) + lane;
#pragma unroll
        for (int j = 0; j < 4; ++j) { const f32x4 a0 = v[2 * j], a1 = v[2 * j + 1]; o16[64 * j] = (v4u){pk2(a0.x, a0.y), pk2(a0.z, a0.w), pk2(a1.x, a1.y), pk2(a1.z, a1.w)}; }
        if (lane == 0) ((_Float16*)rs)[pg8::rs_slot(m)] = (_Float16)rstd;
    }
}
struct ThinRow { f32x4 hv[8]; v4u hw[4]; v4u mw[4]; };
template <bool HIN_F32>
__device__ __forceinline__ void thin_load(ThinRow& r, const void* hin, const bf16* mo, int m, int lane) {
    const GAS v4u* mr = (const GAS v4u*)(mo + (size_t)m * D) + lane;
    if (HIN_F32) { const GAS f32x4* hr = (const GAS f32x4*)((const float*)hin + (size_t)m * D) + 2 * lane;
#pragma unroll
        for (int j = 0; j < 4; ++j) { r.mw[j] = THIN_NT ? __builtin_nontemporal_load(mr + 64 * j) : mr[64 * j]; r.hv[2 * j] = hr[128 * j]; r.hv[2 * j + 1] = hr[128 * j + 1]; } }
    else { const GAS v4u* hr = (const GAS v4u*)((const bf16*)hin + (size_t)m * D) + lane;
#pragma unroll
        for (int j = 0; j < 4; ++j) { r.mw[j] = THIN_NT ? __builtin_nontemporal_load(mr + 64 * j) : mr[64 * j]; r.hw[j] = (THIN_NT > 1) ? __builtin_nontemporal_load(hr + 64 * j) : hr[64 * j]; } }
}
template <bool HIN_F32, bool HOUT_F32, bool NORM_A>
__device__ __forceinline__ void thin_proc(ThinRow& r, const f32x4 (&gp)[8], const float* gnext, void* hout, float* A, int m, int lane) {
    f32x4 mv[8]; float ss = 0.f;
#pragma unroll
    for (int j = 0; j < 4; ++j) { const v4u w = r.mw[j];
        mv[2 * j] = (f32x4){bfw(w.x, 0), bfw(w.x, 1), bfw(w.y, 0), bfw(w.y, 1)}; mv[2 * j + 1] = (f32x4){bfw(w.z, 0), bfw(w.z, 1), bfw(w.w, 0), bfw(w.w, 1)};
        ss += dot4(mv[2 * j]) + dot4(mv[2 * j + 1]);
        if (!HIN_F32) { const v4u hw = r.hw[j]; r.hv[2 * j] = (f32x4){bfw(hw.x, 0), bfw(hw.x, 1), bfw(hw.y, 0), bfw(hw.y, 1)}; r.hv[2 * j + 1] = (f32x4){bfw(hw.z, 0), bfw(hw.z, 1), bfw(hw.w, 0), bfw(hw.w, 1)}; } }
    const float rstd = __builtin_amdgcn_rsqf(wave_sum(ss) * (1.f / D) + EPS);
    float ss2 = 0.f;
#pragma unroll
    for (int j = 0; j < 4; ++j) {
#pragma unroll
        for (int h2 = 0; h2 < 2; ++h2) { const f32x4 gg = gp[2 * j + h2]; r.hv[2 * j + h2] = r.hv[2 * j + h2] + mv[2 * j + h2] * rstd * gg; ss2 += dot4(r.hv[2 * j + h2]); }
        if (HOUT_F32) { GAS f32x4* ho = (GAS f32x4*)((float*)hout + (size_t)m * D) + 2 * lane; ho[128 * j] = r.hv[2 * j]; ho[128 * j + 1] = r.hv[2 * j + 1]; }
        else { GAS v4u* ho = (GAS v4u*)((bf16*)hout + (size_t)m * D) + lane; const f32x4 a0 = r.hv[2 * j], a1 = r.hv[2 * j + 1]; ho[64 * j] = (v4u){pk2(a0.x, a0.y), pk2(a0.z, a0.w), pk2(a1.x, a1.y), pk2(a1.z, a1.w)}; } }
    if (NORM_A) { const float r2 = __builtin_amdgcn_rsqf(wave_sum(ss2) * (1.f / D) + EPS); if (lane == 0) ((_Float16*)A)[pg8::rs_slot(m)] = (_Float16)r2; }
}
template <bool HIN_F32, bool HOUT_F32, bool NORM_A>
__device__ __forceinline__ void thin_phase(const void* hin, const bf16* mo, const float* gpost, const float* gnext, void* hout, float* A, int gw, int NGW, int lane) {
    asm volatile("" : "+v"(lane));
    f32x4 gp[8];
#pragma unroll
    for (int j = 0; j < 4; ++j) { gp[2 * j] = ((const GAS f32x4*)gpost)[2 * lane + 128 * j]; gp[2 * j + 1] = ((const GAS f32x4*)gpost)[2 * lane + 128 * j + 1]; }
    ThinRow r0, r1;
    if (gw < M) thin_load<HIN_F32>(r0, hin, mo, gw, lane);
    for (int m = gw; m < M; m += 2 * NGW) {
        const bool has1 = (m + NGW < M);
        if (has1) thin_load<HIN_F32>(r1, hin, mo, m + NGW, lane);
        thin_proc<HIN_F32, HOUT_F32, NORM_A>(r0, gp, gnext, hout, A, m, lane);
        if (m + 2 * NGW < M) thin_load<HIN_F32>(r0, hin, mo, m + 2 * NGW, lane);
        if (has1) thin_proc<HIN_F32, HOUT_F32, NORM_A>(r1, gp, gnext, hout, A, m + NGW, lane);
    }
}

__device__ __forceinline__ void hgrn_naive_phase(const bf16* proj, const float* lb_logits, int j, const float* out_norm, bf16* Y, LAS unsigned char* lds, int tid, int G) {
    asm volatile("" : "+v"(tid));
    LAS float* Q = (LAS float*)(lds);
    LAS float* F = Q + 2048; LAS float* KK = F + 2048; LAS float* V = KK + 2048; LAS float* Gt = V + 2048;
    LAS float* Po = Gt + 2048;
    const int tok = tid >> 5, c4 = (tid & 31) * 4, v = tid & 127, kg = tid >> 7;
    for (int u = blockIdx.x; u < BATCH * HG_HEADS; u += G) {
        const int b = u / HG_HEADS, hd = u % HG_HEADS;
        float lb[4], lbf[4], onw[4];
#pragma unroll
        for (int i = 0; i < 4; ++i) { const int ch = hd * HG_K + c4 + i; const float l0 = lb_logits[ch], l1 = lb_logits[2048 + ch];
            lb[i] = (j == 0) ? 0.f : 1.0f / (1.0f + __expf(l0 - l1)); lbf[i] = fmaxf(lb[i], 1e-30f); onw[i] = out_norm[c4 + i]; }
        float S[32];
#pragma unroll
        for (int i = 0; i < 32; ++i) S[i] = 0.f;
        for (int t0 = 0; t0 < SEQ; t0 += 16) {
            { const size_t row = (size_t)b * SEQ + t0 + tok; const bf16* pr = proj + row * HG_PROJ + hd * HG_K + c4;
              const v2u zq = *(const GAS v2u*)(pr), zf = *(const GAS v2u*)(pr + 2048), zi = *(const GAS v2u*)(pr + 4096), zg = *(const GAS v2u*)(pr + 6144);
              const unsigned qw[2] = {zq.x, zq.y}, fw[2] = {zf.x, zf.y}, iw[2] = {zi.x, zi.y}, gw2[2] = {zg.x, zg.y};
              f32x4 qv, fv, kv, vv, gv;
#pragma unroll
              for (int i = 0; i < 4; ++i) { const float a = bfw(qw[i >> 1], i & 1); qv[i] = a * sigm(a); const float z = bfw(fw[i >> 1], i & 1); fv[i] = lbf[i] + (1.0f - lb[i]) * sigm(z); kv[i] = (1.0f - lb[i]) * sigm(-z); vv[i] = bfw(iw[i >> 1], i & 1); gv[i] = bfw(gw2[i >> 1], i & 1); }
              const int o = tok * 128 + c4;
              *(LAS f32x4*)(Q + o) = qv; *(LAS f32x4*)(F + o) = fv; *(LAS f32x4*)(KK + o) = kv; *(LAS f32x4*)(V + o) = vv; *(LAS f32x4*)(Gt + o) = gv; }
            __syncthreads();
            for (int t = 0; t < 16; ++t) {
                const float vt = V[t * 128 + v]; float po = 0.f;
#pragma unroll
                for (int i4 = 0; i4 < 8; ++i4) { const int o = t * 128 + kg * 32 + i4 * 4; const f32x4 f4 = *(const LAS f32x4*)(F + o), k4 = *(const LAS f32x4*)(KK + o), q4 = *(const LAS f32x4*)(Q + o);
#pragma unroll
                    for (int e = 0; e < 4; ++e) { S[i4 * 4 + e] = f4[e] * S[i4 * 4 + e] + k4[e] * vt; po += S[i4 * 4 + e] * q4[e]; } }
                Po[(t * 4 + kg) * 128 + v] = po;
            }
            __syncthreads();
            { f32x4 o4 = *(const LAS f32x4*)(Po + (tok * 4 + 0) * 128 + c4);
#pragma unroll
              for (int g2 = 1; g2 < 4; ++g2) o4 = o4 + *(const LAS f32x4*)(Po + (tok * 4 + g2) * 128 + c4);
              float ss = dot4(o4);
#pragma unroll
              for (int o = 1; o < 32; o <<= 1) ss += __shfl_xor(ss, o);
              const float rstd = 1.0f / sqrtf(ss * (1.f / 128.f) + EPS);
              const f32x4 gv = *(const LAS f32x4*)(Gt + tok * 128 + c4);
              float y[4];
#pragma unroll
              for (int i = 0; i < 4; ++i) y[i] = o4[i] * rstd * onw[i] * (gv[i] * sigm(gv[i]));
              const size_t row = (size_t)b * SEQ + t0 + tok;
              *(GAS unsigned long long*)(Y + row * D + hd * HG_K + c4) = (unsigned long long)pk2(y[0], y[1]) | ((unsigned long long)pk2(y[2], y[3]) << 32); }
            __syncthreads();
        }
    }
}

__device__ __forceinline__ void gmlp_naive_phase(const bf16* z, const float* ln_g, const float* ln_b, const float* wst, const float* b_s, bf16* Y, LAS unsigned char* lds, int tid, int G) {
    asm volatile("" : "+v"(tid));
    LAS float* Vn = (LAS float*)(lds);
    LAS float* WT = Vn + 16384;
    LAS float* ST = (LAS float*)(lds + XTRA_OFF);
    const int lane = tid & 63, wave = tid >> 6;
    for (int u = blockIdx.x; u < BATCH * (SEQ / GM_C); u += G) {
        const size_t row0 = (size_t)u * GM_C;
        for (int r = wave * 16; r < wave * 16 + 16; ++r) {
            const bf16* vr = z + (row0 + r) * GM_PROJ + 2048 + lane * 8;
            float x[32]; float s = 0.f;
#pragma unroll
            for (int jj = 0; jj < 4; ++jj) { const v4u w = *(const GAS v4u*)(vr + 512 * jj); const unsigned ww[4] = {w.x, w.y, w.z, w.w};
#pragma unroll
                for (int e = 0; e < 4; ++e) { x[jj * 8 + 2 * e] = __builtin_bit_cast(float, ww[e] << 16); x[jj * 8 + 2 * e + 1] = __builtin_bit_cast(float, ww[e] & 0xffff0000u); s += x[jj * 8 + 2 * e] + x[jj * 8 + 2 * e + 1]; } }
            const float mean = wave_sum(s) * (1.f / 2048.f); float q = 0.f;
#pragma unroll
            for (int e = 0; e < 32; ++e) { const float d = x[e] - mean; q += d * d; }
            const float rstd = 1.0f / sqrtf(wave_sum(q) * (1.f / 2048.f) + EPS);
            if (lane == 0) { ST[2 * r] = mean; ST[2 * r + 1] = rstd; }
        }
        __syncthreads();
        for (int g = 0; g < GM_G; ++g) {
#pragma unroll
            for (int i = 0; i < 4; ++i) { const int s = (tid >> 4) + 32 * i, c8 = (tid & 15) * 8;
                const v4u w = *(const GAS v4u*)(z + (row0 + s) * GM_PROJ + 2048 + g * GM_C + c8); const unsigned ww[4] = {w.x, w.y, w.z, w.w};
                const float mean = ST[2 * s], rstd = ST[2 * s + 1];
                const f32x4 g0 = *(const GAS f32x4*)(ln_g + g * GM_C + c8), g1 = *(const GAS f32x4*)(ln_g + g * GM_C + c8 + 4), b0 = *(const GAS f32x4*)(ln_b + g * GM_C + c8), b1 = *(const GAS f32x4*)(ln_b + g * GM_C + c8 + 4);
                f32x4 o0, o1;
                o0.x = (__builtin_bit_cast(float, ww[0] << 16) - mean) * rstd * g0.x + b0.x; o0.y = (__builtin_bit_cast(float, ww[0] & 0xffff0000u) - mean) * rstd * g0.y + b0.y;
                o0.z = (__builtin_bit_cast(float, ww[1] << 16) - mean) * rstd * g0.z + b0.z; o0.w = (__builtin_bit_cast(float, ww[1] & 0xffff0000u) - mean) * rstd * g0.w + b0.w;
                o1.x = (__builtin_bit_cast(float, ww[2] << 16) - mean) * rstd * g1.x + b1.x; o1.y = (__builtin_bit_cast(float, ww[2] & 0xffff0000u) - mean) * rstd * g1.y + b1.y;
                o1.z = (__builtin_bit_cast(float, ww[3] << 16) - mean) * rstd * g1.z + b1.z; o1.w = (__builtin_bit_cast(float, ww[3] & 0xffff0000u) - mean) * rstd * g1.w + b1.w;
                *(LAS f32x4*)(Vn + s * 128 + c8) = o0; *(LAS f32x4*)(Vn + s * 128 + c8 + 4) = o1; }
#pragma unroll
            for (int i = 0; i < 8; ++i) { const int e4 = tid + 512 * i; *(LAS f32x4*)(WT + e4 * 4) = *(const GAS f32x4*)(wst + (size_t)g * 16384 + e4 * 4); }
            __syncthreads();
            { int tid2 = tid; asm volatile("" : "+v"(tid2)); const int c = tid2 & 127, tq = tid2 >> 7; float acc[32];
#pragma unroll
              for (int i = 0; i < 32; ++i) acc[i] = 0.f;
              const int smax = tq * 32 + 32;
              for (int s = 0; s < smax; ++s) { const float vn = Vn[s * 128 + c];
#pragma unroll
                  for (int i4 = 0; i4 < 8; ++i4) { const f32x4 w4 = *(const LAS f32x4*)(WT + s * 128 + tq * 32 + i4 * 4);
#pragma unroll
                      for (int e = 0; e < 4; ++e) acc[i4 * 4 + e] += w4[e] * vn; } }
#pragma unroll
              for (int i = 0; i < 32; ++i) { const int t = tq * 32 + i; const size_t row = row0 + t;
                  const float uu = bf2f(z[row * GM_PROJ + g * GM_C + c]); const float yv = uu * (acc[i] + b_s[g * GM_C + t]);
                  Y[row * D + g * GM_C + c] = (bf16)f2bf(yv); } }
            __syncthreads();
        }
    }
}


__device__ __forceinline__ void gmlp_mfma_phase(const bf16* z, const float* ln_g, const float* ln_b, const bf16* wsb, const float* b_s, bf16* Y, LAS unsigned char* lds, int tid, int G) {
    asm volatile("" : "+v"(tid));
    constexpr int VSTR = 272;
    LAS float* ST = (LAS float*)(lds + XTRA_OFF);
    const int lane = tid & 63, wave = __builtin_amdgcn_readfirstlane(tid >> 6);
    const int l15 = lane & 15, lg = lane >> 4;
    for (int u = blockIdx.x; u < BATCH * (SEQ / GM_C); u += G) {
        const size_t row0 = (size_t)u * GM_C;
#pragma unroll 1
        for (int rb = 0; rb < 4; ++rb) {
            v4u raw4[4][4];
#pragma unroll
            for (int q = 0; q < 4; ++q) { const bf16* vr = z + (row0 + wave * 16 + rb * 4 + q) * GM_PROJ + 2048 + lane * 8;
#pragma unroll
                for (int jj = 0; jj < 4; ++jj) raw4[q][jj] = *(const GAS v4u*)(vr + 512 * jj); }
#pragma unroll
            for (int q = 0; q < 4; ++q) { float x[32]; float sm = 0.f;
#pragma unroll
                for (int jj = 0; jj < 4; ++jj) { const v4u w = raw4[q][jj]; const unsigned ww[4] = {w.x, w.y, w.z, w.w};
#pragma unroll
                    for (int e = 0; e < 4; ++e) { x[jj * 8 + 2 * e] = bfw(ww[e], 0); x[jj * 8 + 2 * e + 1] = bfw(ww[e], 1); sm += x[jj * 8 + 2 * e] + x[jj * 8 + 2 * e + 1]; } }
                const float mean = wave_sum(sm) * (1.f / 2048.f); float qq = 0.f;
#pragma unroll
                for (int e = 0; e < 32; ++e) { const float d = x[e] - mean; qq += d * d; }
                const float rstd = __builtin_amdgcn_rsqf(wave_sum(qq) * (1.f / 2048.f) + EPS);
                if (lane == 0) { const int r = wave * 16 + rb * 4 + q; ST[2 * r] = mean; ST[2 * r + 1] = rstd; } }
        }
        const bf16* src0 = z + (row0 + 16 * wave) * GM_PROJ + 2048 + 2 * lane;
        unsigned raw[16];
#pragma unroll
        for (int i = 0; i < 16; ++i) raw[i] = *(const GAS unsigned*)(src0 + (size_t)i * GM_PROJ);
        pg8::f32x2 lg_n = *(const GAS pg8::f32x2*)(ln_g + 2 * lane), lb_n = *(const GAS pg8::f32x2*)(ln_b + 2 * lane);
        LBAR();
        for (int g = 0; g < GM_G; ++g) {
            LAS unsigned char* VT = lds + (g & 1) * (128 * VSTR);
            {
                const int cp = lane;
                const float g0 = lg_n.x, g1 = lg_n.y, b0 = lb_n.x, b1 = lb_n.y;
                if (g + 1 < GM_G) { lg_n = *(const GAS pg8::f32x2*)(ln_g + (g + 1) * GM_C + 2 * lane); lb_n = *(const GAS pg8::f32x2*)(ln_b + (g + 1) * GM_C + 2 * lane); }
                unsigned lo[8], hi[8];
#pragma unroll
                for (int i = 0; i < 8; ++i) { const f32x4 st = *(const LAS f32x4*)(ST + 2 * (16 * wave + 2 * i));
                    const float x00 = (bfw(raw[2 * i], 0) - st.x) * st.y * g0 + b0, x01 = (bfw(raw[2 * i], 1) - st.x) * st.y * g1 + b1;
                    const float x10 = (bfw(raw[2 * i + 1], 0) - st.z) * st.w * g0 + b0, x11 = (bfw(raw[2 * i + 1], 1) - st.z) * st.w * g1 + b1;
                    lo[i] = pk2(x00, x10); hi[i] = pk2(x01, x11); }
                LAS unsigned char* d0 = VT + (2 * cp) * VSTR + 32 * wave;
                *(LAS v4u*)(d0) = (v4u){lo[0], lo[1], lo[2], lo[3]}; *(LAS v4u*)(d0 + 16) = (v4u){lo[4], lo[5], lo[6], lo[7]};
                *(LAS v4u*)(d0 + VSTR) = (v4u){hi[0], hi[1], hi[2], hi[3]}; *(LAS v4u*)(d0 + VSTR + 16) = (v4u){hi[4], hi[5], hi[6], hi[7]};
            }
            if (g + 1 < GM_G) {
#pragma unroll
                for (int i = 0; i < 16; ++i) raw[i] = *(const GAS unsigned*)(src0 + (g + 1) * GM_C + (size_t)i * GM_PROJ);
            }
            const int t = 16 * wave + l15; const size_t row = row0 + t;
            const bf16* up = z + row * GM_PROJ + g * GM_C + 4 * lg;
            v2u uu[8];
#pragma unroll
            for (int ct = 0; ct < 8; ++ct) uu[ct] = *(const GAS v2u*)(up + 16 * ct);
            const float bs = b_s[g * GM_C + t];
            const int nk = (wave >> 1) + 1;
            const bf16* wrow = wsb + ((size_t)g * GM_C + 16 * wave + l15) * GM_C + 8 * lg;
            bf16x8 wf[4];
#pragma unroll
            for (int ks = 0; ks < 4; ++ks) if (ks < nk) wf[ks] = *(const GAS bf16x8*)(wrow + 32 * ks);
            LBAR();
            f32x4 acc[8];
#pragma unroll
            for (int ct = 0; ct < 8; ++ct) acc[ct] = (f32x4){0.f, 0.f, 0.f, 0.f};
#pragma unroll
            for (int ks = 0; ks < 4; ++ks) if (ks < nk) {
#pragma unroll
                for (int ct = 0; ct < 8; ++ct) { const bf16x8 vf = *(const LAS bf16x8*)(VT + (16 * ct + l15) * VSTR + 64 * ks + 16 * lg);
                    acc[ct] = __builtin_amdgcn_mfma_f32_16x16x32_bf16(vf, wf[ks], acc[ct], 0, 0, 0); }
            }
            { bf16* yp = Y + row * D + g * GM_C + 4 * lg;
#pragma unroll
              for (int ct = 0; ct < 8; ++ct) { const unsigned ux = uu[ct].x, uy = uu[ct].y;
                  v2u o; o.x = pk2(bfw(ux, 0) * (acc[ct][0] + bs), bfw(ux, 1) * (acc[ct][1] + bs)); o.y = pk2(bfw(uy, 0) * (acc[ct][2] + bs), bfw(uy, 1) * (acc[ct][3] + bs));
                  *(GAS v2u*)(yp + 16 * ct) = o; } }
        }
        LBAR();
    }
}

typedef __bf16 bf16x2_t __attribute__((ext_vector_type(2)));
__device__ __forceinline__ unsigned cvtpk(float lo, float hi) { const pg8::f32x2 v = {lo, hi}; return __builtin_bit_cast(unsigned, __builtin_convertvector(v, bf16x2_t)); }
__device__ __forceinline__ void hgrn_mfma_phase(const bf16* proj, const float* lb_logits, int j, const float* out_norm, bf16* Y, LAS unsigned char* lds, int tid, int G) {
    asm volatile("" : "+v"(tid));
    constexpr int QS = 272, TS = 80, OS = 528;
    LAS unsigned char* const QT = lds;
    LAS unsigned char* const KT = lds + 8704;
    LAS unsigned char* const KHT = lds + 17408;
    LAS unsigned char* const VT = lds + 27648;
    LAS unsigned char* const AM = lds + 37888;
    LAS unsigned char* const OB = lds + 40448;
    LAS unsigned char* const GT = lds + 57344;
    LAS float* const TOT = (LAS float*)(lds + 65536);
    LAS float* const DL = (LAS float*)(lds + 69632);
    const int lane = tid & 63, wave = __builtin_amdgcn_readfirstlane(tid >> 6), l15 = lane & 15, lg = lane >> 4;
    const int t_o = tid >> 4, v8 = (tid & 15) * 8;
    for (int u = blockIdx.x; u < BATCH * HG_HEADS; u += G) {
        const int b = u / HG_HEADS, hd = u % HG_HEADS;
        float lbf[2], oml[2];
#pragma unroll
        for (int e = 0; e < 2; ++e) { const int ch = hd * HG_K + 2 * lane + e; const float l0 = lb_logits[ch], l1 = lb_logits[2048 + ch];
            const float lb = (j == 0) ? 0.f : 1.0f / (1.0f + __expf(l0 - l1)); lbf[e] = fmaxf(lb, 1e-30f); oml[e] = 1.0f - lb; }
        float onw[8];
#pragma unroll
        for (int i = 0; i < 8; ++i) onw[i] = out_norm[v8 + i];
        f32x4 S[8];
#pragma unroll
        for (int kt = 0; kt < 8; ++kt) S[kt] = (f32x4){0.f, 0.f, 0.f, 0.f};
        const bf16* base = proj + ((size_t)b * SEQ + 4 * wave) * HG_PROJ + hd * HG_K + 2 * lane;
        unsigned rq[4], rf[4], ri[4], rg[4];
#pragma unroll
        for (int i = 0; i < 4; ++i) { const bf16* p = base + (size_t)i * HG_PROJ; rq[i] = *(const GAS unsigned*)p; rf[i] = *(const GAS unsigned*)(p + 2048); ri[i] = *(const GAS unsigned*)(p + 4096); rg[i] = *(const GAS unsigned*)(p + 6144); }
        for (int t0 = 0; t0 < SEQ; t0 += 32) {
            float q[4][2], kk[4][2], cs[4][2];
#pragma unroll
            for (int i = 0; i < 4; ++i)
#pragma unroll
                for (int e = 0; e < 2; ++e) { const float zq = bfw(rq[i], e); q[i][e] = zq * __builtin_amdgcn_rcpf(1.0f + __builtin_amdgcn_exp2f(-1.4426950408889634f * zq));
                    const float zf = fmaxf(bfw(rf[i], e), -80.f); const float en = __builtin_amdgcn_exp2f(-1.4426950408889634f * zf), sg = __builtin_amdgcn_rcpf(1.0f + en);
                    const float lf = __builtin_amdgcn_logf(lbf[e] + oml[e] * sg); kk[i][e] = oml[e] * en * sg; cs[i][e] = (i == 0) ? lf : cs[i - 1][e] + lf; }
            *(LAS pg8::f32x2*)(TOT + wave * 128 + 2 * lane) = (pg8::f32x2){cs[3][0], cs[3][1]};
#pragma unroll
            for (int i = 0; i < 4; ++i) *(LAS unsigned*)(GT + (4 * wave + i) * 256 + 4 * lane) = rg[i];
            *(LAS v2u*)(VT + (2 * lane) * TS + 8 * wave) = (v2u){(ri[0] & 0xffffu) | (ri[1] << 16), (ri[2] & 0xffffu) | (ri[3] << 16)};
            *(LAS v2u*)(VT + (2 * lane + 1) * TS + 8 * wave) = (v2u){(ri[0] >> 16) | (ri[1] & 0xffff0000u), (ri[2] >> 16) | (ri[3] & 0xffff0000u)};
            if (t0 + 32 < SEQ) {
#pragma unroll
                for (int i = 0; i < 4; ++i) { const bf16* p = base + (size_t)(t0 + 32 + i) * HG_PROJ; rq[i] = *(const GAS unsigned*)p; rf[i] = *(const GAS unsigned*)(p + 2048); ri[i] = *(const GAS unsigned*)(p + 4096); rg[i] = *(const GAS unsigned*)(p + 6144); }
            }
            LBAR();
            { float pre[2] = {0.f, 0.f}, tot[2] = {0.f, 0.f};
#pragma unroll
              for (int w2 = 0; w2 < 8; ++w2) { const pg8::f32x2 tv = *(const LAS pg8::f32x2*)(TOT + w2 * 128 + 2 * lane); const float a0 = tv.x, a1 = tv.y;
                  tot[0] += a0; tot[1] += a1; if (w2 < wave) { pre[0] += a0; pre[1] += a1; } }
              float kh[4][2];
#pragma unroll
              for (int i = 0; i < 4; ++i) { float qt[2], kt2[2];
#pragma unroll
                  for (int e = 0; e < 2; ++e) { const float bb = pre[e] + cs[i][e];
                      qt[e] = q[i][e] * __builtin_amdgcn_exp2f(bb); kt2[e] = kk[i][e] * __builtin_amdgcn_exp2f(fminf(-bb, 115.f)); kh[i][e] = kk[i][e] * __builtin_amdgcn_exp2f(tot[e] - bb); }
                  *(LAS unsigned*)(QT + (4 * wave + i) * QS + 4 * lane) = cvtpk(qt[0], qt[1]);
                  *(LAS unsigned*)(KT + (4 * wave + i) * QS + 4 * lane) = cvtpk(kt2[0], kt2[1]); }
              *(LAS v2u*)(KHT + (2 * lane) * TS + 8 * wave) = (v2u){cvtpk(kh[0][0], kh[1][0]), cvtpk(kh[2][0], kh[3][0])};
              *(LAS v2u*)(KHT + (2 * lane + 1) * TS + 8 * wave) = (v2u){cvtpk(kh[0][1], kh[1][1]), cvtpk(kh[2][1], kh[3][1])};
              if (wave == 0) *(LAS pg8::f32x2*)(DL + 2 * lane) = (pg8::f32x2){__builtin_amdgcn_exp2f(tot[0]), __builtin_amdgcn_exp2f(tot[1])}; }
            LBAR();
            if (wave < 3) { const int tt = wave ? 1 : 0, st = (wave == 2) ? 1 : 0; f32x4 am = (f32x4){0.f, 0.f, 0.f, 0.f};
#pragma unroll
                for (int k4 = 0; k4 < 4; ++k4) { const bf16x8 a = *(const LAS bf16x8*)(QT + (16 * tt + l15) * QS + 64 * k4 + 16 * lg); const bf16x8 bq = *(const LAS bf16x8*)(KT + (16 * st + l15) * QS + 64 * k4 + 16 * lg);
                    am = __builtin_amdgcn_mfma_f32_16x16x32_bf16(a, bq, am, 0, 0, 0); }
#pragma unroll
                for (int r = 0; r < 4; ++r) { const int tl = 4 * lg + r; const float val = (tt != st || l15 <= tl) ? am[r] : 0.f;
                    *(LAS unsigned short*)(AM + (16 * tt + tl) * TS + (16 * st + l15) * 2) = (unsigned short)f2bf(val); } }
            else if (wave == 3) {
#pragma unroll
                for (int r = 0; r < 4; ++r) *(LAS unsigned short*)(AM + (4 * lg + r) * TS + (16 + l15) * 2) = (unsigned short)0; }
            f32x4 o[2] = {(f32x4){0.f, 0.f, 0.f, 0.f}, (f32x4){0.f, 0.f, 0.f, 0.f}};
#pragma unroll
            for (int k2 = 0; k2 < 4; ++k2) {
                const v4u sb = (v4u){cvtpk(S[2 * k2][0], S[2 * k2][1]), cvtpk(S[2 * k2][2], S[2 * k2][3]), cvtpk(S[2 * k2 + 1][0], S[2 * k2 + 1][1]), cvtpk(S[2 * k2 + 1][2], S[2 * k2 + 1][3])};
                const bf16x8 sfrag = __builtin_bit_cast(bf16x8, sb);
#pragma unroll
                for (int tt = 0; tt < 2; ++tt) { const LAS unsigned char* qp = QT + (16 * tt + l15) * QS + (32 * k2 + 4 * lg) * 2;
                    const v2u lo = *(const LAS v2u*)qp, hi = *(const LAS v2u*)(qp + 32);
                    const bf16x8 a = __builtin_bit_cast(bf16x8, (v4u){lo.x, lo.y, hi.x, hi.y});
                    o[tt] = __builtin_amdgcn_mfma_f32_16x16x32_bf16(a, sfrag, o[tt], 0, 0, 0); }
            }
            LBAR();
            { const bf16x8 vfrag = *(const LAS bf16x8*)(VT + (16 * wave + l15) * TS + 16 * lg);
#pragma unroll
              for (int tt = 0; tt < 2; ++tt) { const bf16x8 a = *(const LAS bf16x8*)(AM + (16 * tt + l15) * TS + 16 * lg); o[tt] = __builtin_amdgcn_mfma_f32_16x16x32_bf16(a, vfrag, o[tt], 0, 0, 0);
#pragma unroll
                  for (int r = 0; r < 4; ++r) *(LAS float*)(OB + (16 * tt + 4 * lg + r) * OS + (16 * wave + l15) * 4) = o[tt][r]; }
#pragma unroll
              for (int kt = 0; kt < 8; ++kt) { const f32x4 d4 = *(const LAS f32x4*)(DL + 16 * kt + 4 * lg); const bf16x8 a = *(const LAS bf16x8*)(KHT + (16 * kt + l15) * TS + 16 * lg);
                  S[kt] = __builtin_amdgcn_mfma_f32_16x16x32_bf16(a, vfrag, S[kt] * d4, 0, 0, 0); } }
            LBAR();
            { const f32x4 o0 = *(const LAS f32x4*)(OB + t_o * OS + v8 * 4), o1 = *(const LAS f32x4*)(OB + t_o * OS + v8 * 4 + 16);
              float ss = dot4(o0) + dot4(o1);
#pragma unroll
              for (int m = 1; m < 16; m <<= 1) ss += __shfl_xor(ss, m);
              const float rstd = __builtin_amdgcn_rsqf(ss * (1.f / 128.f) + EPS);
              const v4u gr = *(const LAS v4u*)(GT + t_o * 256 + v8 * 2); const unsigned gw4[4] = {gr.x, gr.y, gr.z, gr.w};
              float y[8];
#pragma unroll
              for (int i = 0; i < 8; ++i) { const float gv = bfw(gw4[i >> 1], i & 1); const float ov = (i < 4) ? o0[i & 3] : o1[i & 3]; y[i] = ov * rstd * onw[i] * (gv * __builtin_amdgcn_rcpf(1.0f + __builtin_amdgcn_exp2f(-1.4426950408889634f * gv))); }
              if (HG_FILTER(t0, t_o)) *(GAS v4u*)(Y + ((size_t)b * SEQ + t0 + t_o) * D + hd * HG_K + v8) = (v4u){pk2(y[0], y[1]), pk2(y[2], y[3]), pk2(y[4], y[5]), pk2(y[6], y[7])}; }
            LBAR();
        }
    }
}

struct Args { In in; float* out; unsigned char* ws; int ph_lo, ph_hi; };
__global__ void __launch_bounds__(NWAVES * 64, 2) fwd(Args args) {
    extern __shared__ __attribute__((aligned(16))) unsigned char lds_raw[];
    LAS unsigned char* lds = (LAS unsigned char*)lds_raw;
    volatile LAS unsigned* MISC = (volatile LAS unsigned*)(lds + MISC_OFF);
    const int tid = threadIdx.x, lane = tid & 63, wave = __builtin_amdgcn_readfirstlane(tid >> 6);
    const int G = gridDim.x; const int bx = blockIdx.x; const int vcu = (G % 8 == 0) ? (bx % 8) * (G / 8) + bx / 8 : bx;
    const int gw = vcu * NWAVES + wave, NGW = G * NWAVES;
    unsigned char* ws = args.ws; gu32* ctl = (gu32*)(ws + WS_CTL);
    for (int u = tid; u < (LDS_BYTES - LDSCTL_OFF) / 4; u += NWAVES * 64) ((LAS unsigned*)(lds + LDSCTL_OFF))[u] = 0u;
    __syncthreads();
    XcdBarrier bar; bar.bar = (unsigned*)(ctl + CW_BAR); bar.x = 0; bar.st = nullptr;
    if (MK_ONE_LAUNCH) bar = xcd_barrier_post((unsigned*)(ctl + CW_BAR), MISC + 8);
    const int lo = args.ph_lo, hi = args.ph_hi;
#define IN(k) (lo <= (k) && (k) < hi)
#define SEAM(k) do { if (IN(k) && IN((k) + 1)) { xcd_barrier(bar); if (DUP(12)) xcd_barrier(bar); } } while (0)
    const In& in = args.in;
    bf16* const A = (bf16*)(ws + WS_A); bf16* const BIG = (bf16*)(ws + WS_BIG); bf16* const MO = (bf16*)(ws + WS_MO); bf16* const H16 = (bf16*)(ws + WS_MO + 128 * MiB); float* const RS = (float*)(ws + WS_RS);
    float* const out = args.out;

    if (!DIS_THIN && IN(0)) { convert_layer(in, ws, 0, lds, gw, NGW, wave, lane); rows_to_bf16_rs(in.p[0], H16, RS, gw, NGW, lane); }
    SEAM(0);

    for (int L = 0; L < NLOOP; ++L) {
        const int pb = 1 + 9 * L, j = L >> 1;
        if (L & 1) {
            if (EN(0) && IN(pb)) { pg8::Gemm g{H16, (const bf16*)(ws + WS_W1), M, GM_PROJ, D}; pg8::StaticOrder S; S.init(M, GM_PROJ, G, bx);
                pg8::EpiBf16<1, true> E{BIG, GM_PROJ, NT_G1G, RS}; pg8::gemm_phase<pg8::EpiBf16<1, true>, pg8::StaticOrder, PG_ALIGN, PG_SP2>(lds + RING_OFF, g, S, E); if (DUP(0)) { __syncthreads(); pg8::gemm_phase<pg8::EpiBf16<1, true>, pg8::StaticOrder, PG_ALIGN, PG_SP2>(lds + RING_OFF, g, S, E); } }
            SEAM(pb);
            if (!DIS_GMLP && IN(pb + 1)) {
#if GMLP_NAIVE
                gmlp_naive_phase(BIG, in.p[7] + j * 2048, in.p[8] + j * 2048, (const float*)(ws + WS_WST), in.p[10] + j * GM_G * GM_C, A, lds, tid, G);
                if (DUP(6)) gmlp_naive_phase(BIG, in.p[7] + j * 2048, in.p[8] + j * 2048, (const float*)(ws + WS_WST), in.p[10] + j * GM_G * GM_C, A, lds, tid, G);
#else
                gmlp_mfma_phase(BIG, in.p[7] + j * 2048, in.p[8] + j * 2048, (const bf16*)(ws + WS_WSB), in.p[10] + j * GM_G * GM_C, A, lds, tid, G);
                if (DUP(6)) gmlp_mfma_phase(BIG, in.p[7] + j * 2048, in.p[8] + j * 2048, (const bf16*)(ws + WS_WSB), in.p[10] + j * GM_G * GM_C, A, lds, tid, G);
#endif
            }
            SEAM(pb + 1);
        } else {
            if (EN(1) && IN(pb)) { pg8::Gemm g{H16, (const bf16*)(ws + WS_W1), M, HG_PROJ, D}; pg8::StaticOrder S; S.init(M, HG_PROJ, G, bx);
                pg8::EpiBf16<0, true> E{BIG, HG_PROJ, NT_G1H, RS}; pg8::gemm_phase<pg8::EpiBf16<0, true>, pg8::StaticOrder, PG_ALIGN, PG_SP2>(lds + RING_OFF, g, S, E); if (DUP(1)) { __syncthreads(); pg8::gemm_phase<pg8::EpiBf16<0, true>, pg8::StaticOrder, PG_ALIGN, PG_SP2>(lds + RING_OFF, g, S, E); } }
            SEAM(pb);
            if (!DIS_HGRN && IN(pb + 1)) {
#if HGRN_NAIVE
                hgrn_naive_phase(BIG, in.p[3], j, in.p[4] + j * HG_K, A, lds, tid, G);
                if (DUP(7)) hgrn_naive_phase(BIG, in.p[3], j, in.p[4] + j * HG_K, A, lds, tid, G);
#else
                if (HG_BOTH) { hgrn_naive_phase(BIG, in.p[3], j, in.p[4] + j * HG_K, A, lds, tid, G); __syncthreads(); }
                hgrn_mfma_phase(BIG, in.p[3], j, in.p[4] + j * HG_K, A, lds, tid, G);
                if (DUP(7)) hgrn_mfma_phase(BIG, in.p[3], j, in.p[4] + j * HG_K, A, lds, tid, G);
#endif
            }
            SEAM(pb + 1);
        }
        if (EN(2) && IN(pb + 2)) { pg8::Gemm g{A, (const bf16*)(ws + WS_W2), M, D, D}; pg8::StaticOrder S; S.init(M, D, G, bx);
            pg8::EpiBf16<0> E{MO, D, 0, nullptr}; pg8::gemm_phase<pg8::EpiBf16<0>, pg8::StaticOrder, PG_ALIGN, PG_SP2>(lds + RING_OFF, g, S, E); if (DUP(2)) { __syncthreads(); pg8::gemm_phase<pg8::EpiBf16<0>, pg8::StaticOrder, PG_ALIGN, PG_SP2>(lds + RING_OFF, g, S, E); } }
        SEAM(pb + 2);
        if (!DIS_THIN && IN(pb + 3)) { if (L == 0) thin_phase<true, false, true>(in.p[0], MO, in.p[13] + L * D, nullptr, H16, RS, gw, NGW, lane);
            else thin_phase<false, false, true>(H16, MO, in.p[13] + L * D, nullptr, H16, RS, gw, NGW, lane); }
        SEAM(pb + 3);
        if (EN(3) && IN(pb + 4)) { pg8::Gemm g{H16, (const bf16*)(ws + WS_WGU), M, 2 * FF, D}; pg8::StaticOrder S; S.init(M, 2 * FF, G, bx);
            pg8::EpiSwiGLU E{BIG, FF, RS}; pg8::gemm_phase<pg8::EpiSwiGLU, pg8::StaticOrder, PG_ALIGN, PG_SP2>(lds + RING_OFF, g, S, E); if (DUP(10)) { __syncthreads(); pg8::gemm_phase<pg8::EpiSwiGLU, pg8::StaticOrder, PG_ALIGN, PG_SP2, true>(lds + RING_OFF, g, S, E); } if (DUP(3)) { __syncthreads(); pg8::gemm_phase<pg8::EpiSwiGLU, pg8::StaticOrder, PG_ALIGN, PG_SP2>(lds + RING_OFF, g, S, E); } }
        SEAM(pb + 4);
        if (EN(4) && IN(pb + 5)) { pg8::Gemm g{BIG, (const bf16*)(ws + WS_WD), M, D, FF}; pg8::StaticOrder S; S.init(M, D, G, bx);
            pg8::EpiBf16<0> E{MO, D, 0, nullptr}; pg8::gemm_phase<pg8::EpiBf16<0>, pg8::StaticOrder, PG_ALIGN, PG_SP2>(lds + RING_OFF, g, S, E); if (DUP(4)) { __syncthreads(); pg8::gemm_phase<pg8::EpiBf16<0>, pg8::StaticOrder, PG_ALIGN, PG_SP2>(lds + RING_OFF, g, S, E); } }
        SEAM(pb + 5);
        if (!DIS_THIN && IN(pb + 6)) thin_phase<false, false, false>(H16, MO, in.p[15] + L * D, nullptr, H16, nullptr, gw, NGW, lane);
        SEAM(pb + 6);
        if (IN(pb + 7)) {
            if (EN(5)) { pg8::Gemm g{(const bf16*)(ws + WS_PB), (const bf16*)(ws + WS_WPP), M, D, PLE}; pg8::StaticOrder S; S.init(M, D, G, bx);
              pg8::EpiBf16<0> E{MO, D, 0, nullptr}; pg8::gemm_phase<pg8::EpiBf16<0>, pg8::StaticOrder, PG_ALIGN, PG_SP2>(lds + RING_OFF, g, S, E); }
            __syncthreads();
            if (EN(6)) { pg8::Gemm g{H16, (const bf16*)(ws + WS_WPG), M, D, D}; pg8::StaticOrder S; S.init(M, D, G, bx);
              pg8::EpiGateMulBf16 E{MO, D}; pg8::gemm_phase<pg8::EpiGateMulBf16, pg8::StaticOrder, PG_ALIGN, PG_SP2>(lds + RING_OFF, g, S, E); }
            if (DUP(5)) { __syncthreads();
            if (EN(5)) { pg8::Gemm g{(const bf16*)(ws + WS_PB), (const bf16*)(ws + WS_WPP), M, D, PLE}; pg8::StaticOrder S; S.init(M, D, G, bx);
              pg8::EpiBf16<0> E{MO, D, 0, nullptr}; pg8::gemm_phase<pg8::EpiBf16<0>, pg8::StaticOrder, PG_ALIGN, PG_SP2>(lds + RING_OFF, g, S, E); }
            __syncthreads();
            if (EN(6)) { pg8::Gemm g{H16, (const bf16*)(ws + WS_WPG), M, D, D}; pg8::StaticOrder S; S.init(M, D, G, bx);
              pg8::EpiGateMulBf16 E{MO, D}; pg8::gemm_phase<pg8::EpiGateMulBf16, pg8::StaticOrder, PG_ALIGN, PG_SP2>(lds + RING_OFF, g, S, E); }
            }
        }
        SEAM(pb + 7);
        if (!DIS_THIN && IN(pb + 8)) {
            if (L + 1 < DEPTH) { thin_phase<false, false, true>(H16, MO, in.p[21] + L * D, nullptr, H16, RS, gw, NGW, lane); __syncthreads(); convert_layer(in, ws, L + 1, lds, gw, NGW, wave, lane); if (DUP(9)) { __syncthreads(); convert_layer(in, ws, L + 1, lds, gw, NGW, wave, lane); } }
            else thin_phase<false, true, false>(H16, MO, in.p[21] + L * D, nullptr, out, nullptr, gw, NGW, lane);
        }
        SEAM(pb + 8);
    }
#undef IN
#undef SEAM
}

extern "C" void kernel_launch(void* const* d_in, const int* in_sizes, int n_in, void* d_out, int out_size, void* d_ws, size_t ws_size, hipStream_t stream) {
    static int grid = 0;
    if (grid == 0) {
        if (n_in != 22 || out_size != M * D || ws_size < WS_END) { fprintf(stderr, "kernel_launch: unexpected shapes: n_in %d out %d ws %zu (need %zu)\n", n_in, out_size, ws_size, (size_t)WS_END); grid = -1; return; }
        int dev = 0, cus = 0, per_cu = 0;
        if (hipGetDevice(&dev) != hipSuccess || hipDeviceGetAttribute(&cus, hipDeviceAttributeMultiprocessorCount, dev) != hipSuccess) { grid = -1; return; }
        if (hipFuncSetAttribute((const void*)fwd, hipFuncAttributeMaxDynamicSharedMemorySize, LDS_BYTES) != hipSuccess) { fprintf(stderr, "kernel_launch: hipFuncSetAttribute failed\n"); grid = -1; return; }
        if (hipOccupancyMaxActiveBlocksPerMultiprocessor(&per_cu, (const void*)fwd, NWAVES * 64, LDS_BYTES) != hipSuccess || per_cu < 1) fprintf(stderr, "kernel_launch: occupancy query says %d\n", per_cu);
        (void)hipGetLastError();
        grid = cus;
    }
    if (grid < 0) return;
    (void)hipMemsetAsync((char*)d_ws + WS_CTL, 0, CTL_ZERO_BYTES, stream);
    Args a{};
    for (int i = 0; i < 22; ++i) a.in.p[i] = (const float*)d_in[i];
    a.out = (float*)d_out; a.ws = (unsigned char*)d_ws;
#if MK_ONE_LAUNCH
    a.ph_lo = 0; a.ph_hi = NPHASE;
    hipLaunchKernelGGL(fwd, dim3(grid), dim3(NWAVES * 64), LDS_BYTES, stream, a);
#else
    for (int p = 0; p < NPHASE; ++p) { a.ph_lo = p; a.ph_hi = p + 1; hipLaunchKernelGGL(fwd, dim3(grid), dim3(NWAVES * 64), LDS_BYTES, stream, a); }
#endif
}
```
